# Optimizing an MI355X kernel written in HIP

```python
import jax, jax.numpy as jnp
from jax import lax
import numpy as np

D_MODEL = 1024
BATCH = 8
SEQ = 4096
DEPTH = 1

CHUNK = 64
Q_BLOCK = 128
LRU_WIDTH = 512
LRU_BLOCKS = 8
LRU_BLOCK_DIM = LRU_WIDTH // LRU_BLOCKS
CONV_WIDTH = 4
LRU_C = 8.0
MLA_HEADS = 8
QK_NOPE_DIM = 64
QK_ROPE_DIM = 32
V_HEAD_DIM = 64
Q_LORA_RANK = 384
KV_LORA_RANK = 256
ROPE_THETA = 10000.0
MLA_WIDTH = MLA_HEADS * V_HEAD_DIM
D_MIX = LRU_WIDTH + MLA_WIDTH
IN_COLS = 2 * LRU_WIDTH + Q_LORA_RANK + KV_LORA_RANK + QK_ROPE_DIM
D_FF = 2816
EPS = 1e-6

kernel_name = "hybrid_rglru_mla_macaron_sandwich"


def rms_norm(x, g):
    xf = x.astype(jnp.float32)
    y = xf * lax.rsqrt(jnp.mean(xf * xf, axis=-1, keepdims=True) + EPS)
    return (y * g.astype(jnp.float32)).astype(x.dtype)


def swiglu(x, w_gate, w_up, w_down):
    return (jax.nn.silu(x @ w_gate) * (x @ w_up)) @ w_down


def causal_depthwise_conv(x, w, b):
    s = x.shape[1]
    xp = jnp.pad(x, ((0, 0), (CONV_WIDTH - 1, 0), (0, 0)))
    y = b
    for k in range(CONV_WIDTH):
        y = y + xp[:, k:k + s, :] * w[k]
    return y


def rg_lru(x, w_a, b_a, w_x, b_x, lam):
    bsz, s, _ = x.shape
    xb = x.reshape(bsz, s, LRU_BLOCKS, LRU_BLOCK_DIM)
    r = jax.nn.sigmoid((jnp.einsum('bsnd,nde->bsne', xb, w_a).reshape(bsz, s, LRU_WIDTH) + b_a).astype(jnp.float32))
    i = jax.nn.sigmoid((jnp.einsum('bsnd,nde->bsne', xb, w_x).reshape(bsz, s, LRU_WIDTH) + b_x).astype(jnp.float32))
    log_a = -LRU_C * r * jax.nn.softplus(-lam.astype(jnp.float32))
    a = jnp.exp(log_a)
    mult = jnp.sqrt(-jnp.expm1(2.0 * log_a))
    u = mult * (i * x.astype(jnp.float32))

    def combine(left, right):
        a1, b1 = left
        a2, b2 = right
        return a1 * a2, a2 * b1 + b2

    _, h = lax.associative_scan(combine, (a, u), axis=1)
    return h.astype(x.dtype)


def rope(x, cos, sin):
    half = x.shape[-1] // 2
    x1, x2 = x[..., :half], x[..., half:]
    return jnp.concatenate([x1 * cos - x2 * sin, x2 * cos + x1 * sin], axis=-1).astype(x.dtype)


def mla(q_lat, kv_lat, k_rope_raw, positions, q_a_norm, w_q_b, kv_a_norm, w_kv_b):
    bsz, s, _ = q_lat.shape
    q = (rms_norm(q_lat, q_a_norm) @ w_q_b).reshape(bsz, s, MLA_HEADS, QK_NOPE_DIM + QK_ROPE_DIM)
    q_nope, q_pe = q[..., :QK_NOPE_DIM], q[..., QK_NOPE_DIM:]
    kv = (rms_norm(kv_lat, kv_a_norm) @ w_kv_b).reshape(bsz, s, MLA_HEADS, QK_NOPE_DIM + V_HEAD_DIM)
    k_nope, v = kv[..., :QK_NOPE_DIM], kv[..., QK_NOPE_DIM:]

    inv_freq = 1.0 / (ROPE_THETA ** (jnp.arange(0, QK_ROPE_DIM, 2, dtype=jnp.float32) / QK_ROPE_DIM))
    ang = positions.astype(jnp.float32)[..., None] * inv_freq
    cos, sin = jnp.cos(ang), jnp.sin(ang)
    q_pe = rope(q_pe, cos[:, :, None, :], sin[:, :, None, :])
    k_pe = rope(k_rope_raw, cos, sin)

    scale = (QK_NOPE_DIM + QK_ROPE_DIM) ** -0.5
    n_blocks = s // Q_BLOCK
    qn_blocks = q_nope.reshape(bsz, n_blocks, Q_BLOCK, MLA_HEADS, QK_NOPE_DIM).transpose(1, 0, 2, 3, 4)
    qp_blocks = q_pe.reshape(bsz, n_blocks, Q_BLOCK, MLA_HEADS, QK_ROPE_DIM).transpose(1, 0, 2, 3, 4)
    key_chunk = jnp.arange(s) // CHUNK

    def attend(args):
        qn, qp, blk = args
        sc = (jnp.einsum('bqhd,bkhd->bhqk', qn, k_nope)
              + jnp.einsum('bqhd,bkd->bhqk', qp, k_pe)).astype(jnp.float32) * scale
        q_chunk = (blk * Q_BLOCK + jnp.arange(Q_BLOCK)) // CHUNK
        mask = key_chunk[None, :] <= q_chunk[:, None]
        sc = jnp.where(mask[None, None], sc, -1e30)
        p = jax.nn.softmax(sc, axis=-1).astype(v.dtype)
        return jnp.einsum('bhqk,bkhd->bqhd', p, v)

    out = lax.map(attend, (qn_blocks, qp_blocks, jnp.arange(n_blocks)))
    return out.transpose(1, 0, 2, 3, 4).reshape(bsz, s, MLA_WIDTH)


def hybrid_mixer(h, positions, w_in, conv_w, conv_b, w_lru_a, b_lru_a, w_lru_x, b_lru_x,
                 lru_lambda, q_a_norm, w_q_b, kv_a_norm, w_kv_b, w_out):
    proj = h @ w_in
    cuts = [LRU_WIDTH, 2 * LRU_WIDTH, 2 * LRU_WIDTH + Q_LORA_RANK,
            2 * LRU_WIDTH + Q_LORA_RANK + KV_LORA_RANK]
    x_lru, gate, q_lat, kv_lat, k_rope_raw = jnp.split(proj, cuts, axis=-1)
    y_lru = rg_lru(causal_depthwise_conv(x_lru, conv_w, conv_b),
                   w_lru_a, b_lru_a, w_lru_x, b_lru_x, lru_lambda) * jax.nn.gelu(gate)
    y_mla = mla(q_lat, kv_lat, k_rope_raw, positions, q_a_norm, w_q_b, kv_a_norm, w_kv_b)
    return jnp.concatenate([y_lru, y_mla], axis=-1) @ w_out


def setup_inputs(seed: int = 0) -> dict:
    key = jax.random.key(seed)
    ks = iter(jax.random.split(key, 40))
    f32 = jnp.float32

    def nrm(shape, fan_in):
        return jax.random.normal(next(ks), shape, f32) * (fan_in ** -0.5)

    def gain(shape):
        return 1.0 + 0.01 * jax.random.normal(next(ks), shape, f32)

    def bias(shape):
        return 0.01 * jax.random.normal(next(ks), shape, f32)

    L = DEPTH
    x = jax.random.normal(next(ks), (BATCH, SEQ, D_MODEL), f32)
    offset = jax.random.randint(next(ks), (BATCH, 1), 0, 65536, dtype=jnp.int32)
    positions = (offset + jnp.arange(SEQ, dtype=jnp.int32)[None, :]).astype(jnp.int32)

    a0 = jax.random.uniform(next(ks), (L, LRU_WIDTH), f32, 0.9, 0.999)
    sa = a0 ** (1.0 / LRU_C)
    lru_lambda = jnp.log(sa) - jnp.log1p(-sa)

    return {
        "x": x,
        "positions": positions,
        "g_ffn1_pre": gain((L, D_MODEL)),
        "g_ffn1_post": gain((L, D_MODEL)),
        "w_ffn1_gate": nrm((L, D_MODEL, D_FF), D_MODEL),
        "w_ffn1_up": nrm((L, D_MODEL, D_FF), D_MODEL),
        "w_ffn1_down": nrm((L, D_FF, D_MODEL), D_FF),
        "g_mix_pre": gain((L, D_MODEL)),
        "g_mix_post": gain((L, D_MODEL)),
        "w_in": nrm((L, D_MODEL, IN_COLS), D_MODEL),
        "conv_w": nrm((L, CONV_WIDTH, LRU_WIDTH), CONV_WIDTH),
        "conv_b": bias((L, LRU_WIDTH)),
        "w_lru_a": nrm((L, LRU_BLOCKS, LRU_BLOCK_DIM, LRU_BLOCK_DIM), LRU_BLOCK_DIM),
        "b_lru_a": bias((L, LRU_WIDTH)),
        "w_lru_x": nrm((L, LRU_BLOCKS, LRU_BLOCK_DIM, LRU_BLOCK_DIM), LRU_BLOCK_DIM),
        "b_lru_x": bias((L, LRU_WIDTH)),
        "lru_lambda": lru_lambda,
        "q_a_norm": gain((L, Q_LORA_RANK)),
        "w_q_b": nrm((L, Q_LORA_RANK, MLA_HEADS * (QK_NOPE_DIM + QK_ROPE_DIM)), Q_LORA_RANK),
        "kv_a_norm": gain((L, KV_LORA_RANK)),
        "w_kv_b": nrm((L, KV_LORA_RANK, MLA_HEADS * (QK_NOPE_DIM + V_HEAD_DIM)), KV_LORA_RANK),
        "w_out": nrm((L, D_MIX, D_MODEL), D_MIX),
        "g_ffn2_pre": gain((L, D_MODEL)),
        "g_ffn2_post": gain((L, D_MODEL)),
        "w_ffn2_gate": nrm((L, D_MODEL, D_FF), D_MODEL),
        "w_ffn2_up": nrm((L, D_MODEL, D_FF), D_MODEL),
        "w_ffn2_down": nrm((L, D_FF, D_MODEL), D_FF),
    }


def reference(x, positions, g_ffn1_pre, g_ffn1_post, w_ffn1_gate, w_ffn1_up, w_ffn1_down,
              g_mix_pre, g_mix_post, w_in, conv_w, conv_b, w_lru_a, b_lru_a, w_lru_x, b_lru_x,
              lru_lambda, q_a_norm, w_q_b, kv_a_norm, w_kv_b, w_out,
              g_ffn2_pre, g_ffn2_post, w_ffn2_gate, w_ffn2_up, w_ffn2_down):
    h = x
    for l in range(DEPTH):
        f = swiglu(rms_norm(h, g_ffn1_pre[l]), w_ffn1_gate[l], w_ffn1_up[l], w_ffn1_down[l])
        h = h + 0.5 * rms_norm(f, g_ffn1_post[l])
        m = hybrid_mixer(rms_norm(h, g_mix_pre[l]), positions, w_in[l], conv_w[l], conv_b[l],
                         w_lru_a[l], b_lru_a[l], w_lru_x[l], b_lru_x[l], lru_lambda[l],
                         q_a_norm[l], w_q_b[l], kv_a_norm[l], w_kv_b[l], w_out[l])
        h = h + rms_norm(m, g_mix_post[l])
        f = swiglu(rms_norm(h, g_ffn2_pre[l]), w_ffn2_gate[l], w_ffn2_up[l], w_ffn2_down[l])
        h = h + 0.5 * rms_norm(f, g_ffn2_post[l])
    return h
```

```cpp
#include <hip/hip_runtime.h>
#include <cstdio>
#include <cstdint>
namespace pg8 {
#define PG8_LAS __attribute__((address_space(3)))
typedef unsigned short bf16_t;
typedef short bf16x8 __attribute__((ext_vector_type(8)));
typedef float f32x4 __attribute__((ext_vector_type(4)));
typedef unsigned u32x4 __attribute__((ext_vector_type(4)));
constexpr int BM = 256, BK = 64, HALF = 128, HTB = HALF * BK * 2  , STAGE_BYTES = 8 * HTB, NXCD = 8, WGM = 8;

__host__ __device__ __forceinline__ int lds_byte(int r, int c) { const int st = (r >> 4) * 2 + (c >> 5), rr = r & 15, cc = c & 31, ob = rr * 64 + cc * 2; return st * 1024 + (ob ^ (((ob >> 9) & 1) << 5)); }
__host__ __device__ __forceinline__ void stage_rc(int b, int& R, int& C) { const int st = b / 1024, sb = b % 1024, swz = sb ^ (((sb >> 9) & 1) << 5); R = (st >> 1) * 16 + swz / 64; C = (st & 1) * 32 + (swz % 64) / 2; }
__host__ __device__ __forceinline__ int perm32(int rho) { const int n = rho >> 4, i = rho & 15; return 8 * (i >> 2) + 4 * n + (i & 3); }

struct Unit { int pm, pn; };
struct Gemm { const bf16_t* A; const bf16_t* Bt; int M, N, K; };

struct StaticOrder {
    int nM, nN, nwg, G, c;
    __host__ __device__ void init(int M, int N, int G_, int c_) { nM = M / BM; nN = N / BM; nwg = nM * nN; G = G_; c = c_; }
    __host__ __device__ bool next(int i, Unit& u) const {
        const long L = (long)i * G + c; if (L >= nwg) return false;
        int wgid = (int)L; { const int q = nwg / NXCD, r = nwg % NXCD, xcd = wgid % NXCD, off = wgid / NXCD; wgid = (xcd < r ? xcd * (q + 1) : r * (q + 1) + (xcd - r) * q) + off; }
        const int nig = WGM * nN, gid = wgid / nig, fm = gid * WGM, gsz = (nM - fm) < WGM ? (nM - fm) : WGM;
        u.pm = fm + ((wgid % nig) % gsz); u.pn = (wgid % nig) / gsz; return true;
    }
    __device__ __forceinline__ void a_ready(const Unit&) const {}
    __device__ __forceinline__ void done(const Unit&) const {}
};

__device__ __forceinline__ unsigned cvt_pk_bf16(float lo, float hi) { unsigned r; asm volatile("v_cvt_pk_bf16_f32 %0, %1, %2" : "=v"(r) : "v"(lo), "v"(hi)); return r; }

struct EpiBf16 {
    static constexpr bool PERM = true, AFTER_DRAIN = false;
    bf16_t* O; int ldc;
    __device__ __forceinline__ void operator()(const f32x4 (&acc)[2][2][4][2], const Unit& u, int wr, int wc, int fr, int fq) const {
        const int row0 = u.pm * BM + wr * 64 + fr, col0 = u.pn * BM + wc * 32 + 8 * fq;
#pragma unroll
        for (int ai = 0; ai < 2; ++ai)
#pragma unroll
            for (int m = 0; m < 4; ++m) { bf16_t* rowp = O + (size_t)(row0 + ai * HALF + m * 16) * ldc + col0;
#pragma unroll
                for (int bj = 0; bj < 2; ++bj) { const f32x4 v0 = acc[ai][bj][m][0], v1 = acc[ai][bj][m][1];
                    u32x4 w; w.x = cvt_pk_bf16(v0[0], v0[1]); w.y = cvt_pk_bf16(v0[2], v0[3]); w.z = cvt_pk_bf16(v1[0], v1[1]); w.w = cvt_pk_bf16(v1[2], v1[3]);
                    *(u32x4*)(rowp + bj * HALF) = w; } }
    }
};
__device__ __forceinline__ float silu_mul(float g, float u) { return g * __builtin_amdgcn_rcpf(1.0f + __builtin_amdgcn_exp2f(-1.4426950408889634f * g)) * u; }
struct EpiSwiglu {
    static constexpr bool PERM = true, AFTER_DRAIN = false;
    bf16_t* O; int ldc;
    __device__ __forceinline__ void operator()(const f32x4 (&acc)[2][2][4][2], const Unit& u, int wr, int wc, int fr, int fq) const {
        const int row0 = u.pm * BM + wr * 64 + fr, col0 = u.pn * HALF + wc * 32 + 8 * fq;
#pragma unroll
        for (int ai = 0; ai < 2; ++ai)
#pragma unroll
            for (int m = 0; m < 4; ++m) { bf16_t* rowp = O + (size_t)(row0 + ai * HALF + m * 16) * ldc + col0;
                const f32x4 g0 = acc[ai][0][m][0], g1 = acc[ai][0][m][1], u0 = acc[ai][1][m][0], u1 = acc[ai][1][m][1];
                u32x4 w; w.x = cvt_pk_bf16(silu_mul(g0[0], u0[0]), silu_mul(g0[1], u0[1])); w.y = cvt_pk_bf16(silu_mul(g0[2], u0[2]), silu_mul(g0[3], u0[3]));
                w.z = cvt_pk_bf16(silu_mul(g1[0], u1[0]), silu_mul(g1[1], u1[1])); w.w = cvt_pk_bf16(silu_mul(g1[2], u1[2]), silu_mul(g1[3], u1[3]));
                *(u32x4*)rowp = w; }
    }
};
struct EpiF32 {
    static constexpr bool PERM = false, AFTER_DRAIN = false;
    float* C; int ldc;
    __device__ __forceinline__ void operator()(const f32x4 (&acc)[2][2][4][2], const Unit& u, int wr, int wc, int fr, int fq) const {
        const int row0 = u.pm * BM + wr * 64 + fr, col0 = u.pn * BM + wc * 32 + 4 * fq;
#pragma unroll
        for (int ai = 0; ai < 2; ++ai)
#pragma unroll
            for (int m = 0; m < 4; ++m) { float* rowp = C + (size_t)(row0 + ai * HALF + m * 16) * ldc + col0;
#pragma unroll
                for (int bj = 0; bj < 2; ++bj)
#pragma unroll
                    for (int n = 0; n < 2; ++n) *(f32x4*)(rowp + bj * HALF + n * 16) = acc[ai][bj][m][n]; }
    }
};

template <class Epi, class Sched, bool ALIGN_EPI = false, bool SP2 = false>
__device__ __forceinline__ void gemm_phase(PG8_LAS unsigned char* lds, const Gemm g, const Sched& S, const Epi& E) {
    const int tid = threadIdx.x, wid = __builtin_amdgcn_readfirstlane(tid >> 6), lane = tid & 63, wr = wid >> 2, wc = wid & 3, fr = lane & 15, fq = lane >> 4;
    const int K = g.K, nt = K / BK;
    unsigned voffA[2], voffB[2];
#pragma unroll
    for (int i = 0; i < 2; ++i) { int R, C; stage_rc(tid * 16 + i * 8192, R, C); const int Rb = Epi::PERM ? ((R & ~31) + perm32(R & 31)) : R;
        voffA[i] = (unsigned)(R * K + C) * 2u; voffB[i] = (unsigned)(Rb * K + C) * 2u; }
    const size_t kstep = (size_t)(BK * 2);
    const size_t hstep = (size_t)HALF * K * 2;
    const size_t tstep = 2 * hstep;
    const unsigned ldsw = (unsigned)wid * 1024u;
    const int aoff = lds_byte(wr * 64 + fr, fq * 8), boff = lds_byte(wc * 32 + fr, fq * 8);
#define PG8_SA(b, h) (((b) * 2 + (h)) * HTB)
#define PG8_SB(b, h) ((4 + (b) * 2 + (h)) * HTB)
#define PG8_STAGE(bufoff, gbase, voff) do { _Pragma("unroll") for (int _i = 0; _i < 2; ++_i) \
        __builtin_amdgcn_global_load_lds((const unsigned*)((const char*)(gbase) + (voff)[_i]), (PG8_LAS unsigned*)(lds + (bufoff) + ldsw + _i * 8192), 16, 0, 0); } while (0)
#define PG8_LDA(dst, b, h) do { _Pragma("unroll") for (int m = 0; m < 4; ++m) _Pragma("unroll") for (int k = 0; k < 2; ++k) dst[m][k] = *(const PG8_LAS bf16x8*)(lds + PG8_SA(b, h) + aoff + m * 2048 + k * 1024); } while (0)
#define PG8_LDB(dst, b, h) do { _Pragma("unroll") for (int n = 0; n < 2; ++n) _Pragma("unroll") for (int k = 0; k < 2; ++k) dst[n][k] = *(const PG8_LAS bf16x8*)(lds + PG8_SB(b, h) + boff + n * 2048 + k * 1024); } while (0)
#define PG8_MMA(ai, bj, At, Bt) do { __builtin_amdgcn_s_setprio(1); _Pragma("unroll") for (int m = 0; m < 4; ++m) _Pragma("unroll") for (int n = 0; n < 2; ++n) _Pragma("unroll") for (int k = 0; k < 2; ++k) \
        acc[ai][bj][m][n] = __builtin_amdgcn_mfma_f32_16x16x32_bf16(Bt[n][k], At[m][k], acc[ai][bj][m][n], 0, 0, 0); __builtin_amdgcn_s_setprio(0); } while (0)
#define PG8_WAIT_V(n) asm volatile("s_waitcnt vmcnt(" #n ")" ::: "memory")
#define PG8_WAIT_L(n) asm volatile("s_waitcnt lgkmcnt(" #n ")" ::: "memory")
#define PG8_BAR __builtin_amdgcn_s_barrier()
#define PG8_SCHED __builtin_amdgcn_sched_barrier(0)
    Unit cur, nxt; int ui = 0;
    if (!S.next(0, cur)) return;
    f32x4 acc[2][2][4][2];
#pragma unroll
    for (int a = 0; a < 2; ++a)
#pragma unroll
        for (int b = 0; b < 2; ++b)
#pragma unroll
            for (int m = 0; m < 4; ++m)
#pragma unroll
                for (int n = 0; n < 2; ++n) acc[a][b][m][n] = (f32x4){0.f, 0.f, 0.f, 0.f};
    bf16x8 At[4][2], B0[2][2], B1[2][2];
    const char* cA = (const char*)g.A + (size_t)cur.pm * tstep; const char* cB = (const char*)g.Bt + (size_t)cur.pn * tstep;
    S.a_ready(cur);
    if constexpr (SP2) {
        PG8_STAGE(PG8_SB(0, 0), cB, voffB); PG8_STAGE(PG8_SB(0, 1), cB + hstep, voffB); PG8_STAGE(PG8_SA(0, 0), cA, voffA); PG8_STAGE(PG8_SA(0, 1), cA + hstep, voffA);
        if (wr == 1) PG8_BAR;
        PG8_WAIT_V(2); PG8_BAR;
        PG8_STAGE(PG8_SB(1, 0), cB + kstep, voffB); PG8_STAGE(PG8_SA(1, 0), cA + kstep, voffA); PG8_STAGE(PG8_SB(1, 1), cB + hstep + kstep, voffB);
        PG8_WAIT_V(6); PG8_BAR;
    } else {
        PG8_STAGE(PG8_SB(0, 0), cB, voffB); PG8_STAGE(PG8_SA(0, 0), cA, voffA); PG8_STAGE(PG8_SB(0, 1), cB + hstep, voffB); PG8_STAGE(PG8_SA(0, 1), cA + hstep, voffA);
        if (wr == 1) PG8_BAR;
        PG8_WAIT_V(4); PG8_BAR;
        PG8_STAGE(PG8_SB(1, 0), cB + kstep, voffB); PG8_STAGE(PG8_SA(1, 0), cA + kstep, voffA); PG8_STAGE(PG8_SB(1, 1), cB + hstep + kstep, voffB);
        PG8_WAIT_V(6); PG8_BAR;
    }
    for (;;) {
        const bool has_next = S.next(ui + 1, nxt);
        const char* nA = has_next ? (const char*)g.A + (size_t)nxt.pm * tstep : cA; const char* nB = has_next ? (const char*)g.Bt + (size_t)nxt.pn * tstep : cB;
        for (int t = 0; t < nt; t += 2) {
            const bool last = (t == nt - 2);
            const char* a1 = cA + (size_t)(t + 1) * kstep;
            const char* a2 = last ? nA : cA + (size_t)(t + 2) * kstep; const char* b2 = last ? nB : cB + (size_t)(t + 2) * kstep;
            const char* a3 = a2 + kstep; const char* b3 = b2 + kstep;
            if (last && has_next) S.a_ready(nxt);
            if constexpr (SP2) {
            PG8_LDB(B0, 0, 0); PG8_LDB(B1, 0, 1); PG8_SCHED; PG8_LDA(At, 0, 0); PG8_STAGE(PG8_SA(1, 1), a1 + hstep, voffA);
            PG8_WAIT_V(8); PG8_WAIT_L(0); PG8_BAR; PG8_MMA(0, 0, At, B0); PG8_MMA(0, 1, At, B1); PG8_BAR; PG8_SCHED;
            PG8_LDA(At, 0, 1); PG8_STAGE(PG8_SB(0, 0), b2, voffB); PG8_STAGE(PG8_SB(0, 1), b2 + hstep, voffB); PG8_STAGE(PG8_SA(0, 0), a2, voffA);
            PG8_WAIT_V(8); PG8_WAIT_L(0); PG8_BAR; PG8_MMA(1, 0, At, B0); PG8_MMA(1, 1, At, B1); PG8_BAR; PG8_SCHED;
            PG8_LDB(B0, 1, 0); PG8_LDB(B1, 1, 1); PG8_SCHED; PG8_LDA(At, 1, 0); PG8_STAGE(PG8_SA(0, 1), a2 + hstep, voffA);
            PG8_WAIT_V(8); PG8_WAIT_L(0); PG8_BAR; PG8_MMA(0, 0, At, B0); PG8_MMA(0, 1, At, B1); PG8_BAR; PG8_SCHED;
            PG8_LDA(At, 1, 1); PG8_STAGE(PG8_SB(1, 0), b3, voffB); PG8_STAGE(PG8_SB(1, 1), b3 + hstep, voffB); PG8_STAGE(PG8_SA(1, 0), a3, voffA);
            PG8_WAIT_V(8); PG8_WAIT_L(0); PG8_BAR; PG8_MMA(1, 0, At, B0); PG8_MMA(1, 1, At, B1); PG8_BAR; PG8_SCHED;
            } else {
            PG8_LDB(B0, 0, 0); PG8_SCHED; PG8_LDA(At, 0, 0); PG8_STAGE(PG8_SA(1, 1), a1 + hstep, voffA);
            PG8_WAIT_L(8); PG8_BAR; PG8_WAIT_L(0); PG8_MMA(0, 0, At, B0); PG8_BAR; PG8_SCHED;
            PG8_LDB(B1, 0, 1); PG8_STAGE(PG8_SB(0, 0), b2, voffB);
            PG8_BAR; PG8_WAIT_L(0); PG8_MMA(0, 1, At, B1); PG8_BAR;
            PG8_LDA(At, 0, 1); PG8_STAGE(PG8_SA(0, 0), a2, voffA);
            PG8_BAR; PG8_WAIT_L(0); PG8_MMA(1, 0, At, B0); PG8_BAR; PG8_SCHED;
            PG8_STAGE(PG8_SB(0, 1), b2 + hstep, voffB);
            PG8_WAIT_V(6); PG8_BAR; PG8_MMA(1, 1, At, B1); PG8_BAR;
            PG8_LDB(B0, 1, 0); PG8_SCHED; PG8_LDA(At, 1, 0); PG8_STAGE(PG8_SA(0, 1), a2 + hstep, voffA);
            PG8_WAIT_L(8); PG8_BAR; PG8_WAIT_L(0); PG8_MMA(0, 0, At, B0); PG8_BAR; PG8_SCHED;
            PG8_LDB(B1, 1, 1); PG8_STAGE(PG8_SB(1, 0), b3, voffB);
            PG8_BAR; PG8_WAIT_L(0); PG8_MMA(0, 1, At, B1); PG8_BAR;
            PG8_LDA(At, 1, 1); PG8_STAGE(PG8_SA(1, 0), a3, voffA);
            PG8_BAR; PG8_WAIT_L(0); PG8_MMA(1, 0, At, B0); PG8_BAR; PG8_SCHED;
            PG8_STAGE(PG8_SB(1, 1), b3 + hstep, voffB);
            PG8_WAIT_V(6); PG8_BAR; PG8_MMA(1, 1, At, B1); PG8_BAR;
            }
        }
        if constexpr (ALIGN_EPI) { if (wr == 0) PG8_BAR; }
        if constexpr (!Epi::AFTER_DRAIN) { E(acc, cur, wr, wc, fr, fq); S.done(cur); }
        if (!has_next) break;
#pragma unroll
        for (int a = 0; a < 2; ++a)
#pragma unroll
            for (int b = 0; b < 2; ++b)
#pragma unroll
                for (int m = 0; m < 4; ++m)
#pragma unroll
                    for (int n = 0; n < 2; ++n) acc[a][b][m][n] = (f32x4){0.f, 0.f, 0.f, 0.f};
        cur = nxt; cA = nA; cB = nB; ++ui;
        if constexpr (ALIGN_EPI) { if (wr == 1) PG8_BAR; }
    }
    PG8_WAIT_V(0);
    if constexpr (!ALIGN_EPI) { if (wr == 0) PG8_BAR; }
    PG8_BAR;
    if constexpr (Epi::AFTER_DRAIN) { E.fused(acc, cur, wr, wc, fr, fq, lds, wid, lane); S.done(cur); }
#undef PG8_SA
#undef PG8_SB
#undef PG8_STAGE
#undef PG8_LDA
#undef PG8_LDB
#undef PG8_MMA
#undef PG8_WAIT_V
#undef PG8_WAIT_L
#undef PG8_BAR
#undef PG8_SCHED
}
}

#ifndef PG8_SP2
#define PG8_SP2 true
#endif
#ifndef PG8_ALIGN
#define PG8_ALIGN true
#endif

constexpr int NWAVES = 8;
#ifndef MK_ONE_LAUNCH
#define MK_ONE_LAUNCH 1
#endif
constexpr int N_PHASES = 14;

constexpr int BATCH = 8, SEQ = 4096, D = 1024, FF = 2816, M = BATCH * SEQ;
constexpr int LRU_W = 512, NHEAD = 8, QK_NOPE = 64, QK_ROPE = 32, VDIM = 64, QLORA = 384, KVLORA = 256;
constexpr int IN_COLS = 2 * LRU_W + QLORA + KVLORA + QK_ROPE;
constexpr int IN_PAD = 1792;
constexpr int QW = NHEAD * (QK_NOPE + QK_ROPE);
constexpr int KVW = NHEAD * (QK_NOPE + VDIM);
constexpr int C_QLAT = 2 * LRU_W, C_KVLAT = C_QLAT + QLORA, C_KROPE = C_KVLAT + KVLORA;
constexpr float EPS = 1e-6f;
constexpr float QSCALE = 0.14724445f;
constexpr int NCHUNK = SEQ / 64;

constexpr size_t MiB = 1u << 20;
constexpr size_t WS_CTL = 0, CTL_ZERO_BYTES = 1 * MiB;
constexpr size_t WS_W1GU = 2 * MiB, WS_W1D = 13 * MiB, WS_W2GU = 19 * MiB, WS_W2D = 30 * MiB, WS_WIN = 36 * MiB, WS_WQB = 40 * MiB, WS_WKVB = 41 * MiB, WS_WLRU = 42 * MiB, WS_WOUT = 43 * MiB;
constexpr size_t WS_XN = 48 * MiB;
constexpr size_t WS_QLN = 48 * MiB, WS_KVLN = 72 * MiB;
constexpr size_t WS_Y = 48 * MiB;
constexpr size_t WS_HB = 112 * MiB;
constexpr size_t WS_PROJ = 112 * MiB, WS_GATES = 224 * MiB;
constexpr size_t WS_F = 288 * MiB;
constexpr size_t WS_Q = 288 * MiB, WS_KV = 336 * MiB;
constexpr size_t WS_KPE = 416 * MiB, WS_COS = 418 * MiB, WS_SIN = 420 * MiB, WS_AGG = 422 * MiB;
constexpr size_t WS_XC = 424 * MiB;
constexpr size_t WS_END = 456 * MiB;
constexpr int CW_TMO = 0, CW_CODE = 1;
constexpr int CW_BAR = 4096;

constexpr int RING_OFF = 0, RING_BYTES = 131072;
constexpr int LDSCTL_OFF = RING_BYTES, MISC_OFF = LDSCTL_OFF + 320;
constexpr int LDS_BYTES = 147456;

#define GAS __attribute__((address_space(1)))
#define LAS __attribute__((address_space(3)))
typedef unsigned short bf16;
typedef unsigned v4u __attribute__((ext_vector_type(4)));
typedef float f32x4 __attribute__((ext_vector_type(4)));
typedef short bf16x8 __attribute__((ext_vector_type(8)));
typedef GAS unsigned gu32;
typedef GAS unsigned long long gu64;
#define RLX_AGENT __ATOMIC_RELAXED, __HIP_MEMORY_SCOPE_AGENT
#define LDS_WAIT() asm volatile("s_waitcnt lgkmcnt(0)" ::: "memory")
#define VM_WAIT() asm volatile("s_waitcnt vmcnt(0)" ::: "memory")
__device__ __forceinline__ unsigned long long rt() { return __builtin_amdgcn_s_memrealtime(); }
__device__ __forceinline__ unsigned f2bf(float f) { unsigned u = __builtin_bit_cast(unsigned, f); return (u + 0x7fffu + ((u >> 16) & 1u)) >> 16; }
__device__ __forceinline__ unsigned pk2(float lo, float hi) { return f2bf(lo) | (f2bf(hi) << 16); }

#define XB_TMO      128
#define XB_XCNT(j)  (256  + 64 * (j))
#define XB_XSUB(j)  (1280 + 64 * (j))
#define XB_XGEN(j)  (2304 + 64 * (j))
#define XB_TOP      3328
#define XB_TOPGEN   3392
#define XCD_BAR_WORDS 3456
#define XB_SPIN_CAP (1u << 18)

__device__ __forceinline__ unsigned xb_ld(unsigned* p)              { return __hip_atomic_load(p, __ATOMIC_RELAXED, __HIP_MEMORY_SCOPE_AGENT); }
__device__ __forceinline__ unsigned xb_add(unsigned* p, unsigned v) { return __hip_atomic_fetch_add(p, v, __ATOMIC_RELAXED, __HIP_MEMORY_SCOPE_AGENT); }
__device__ __forceinline__ unsigned xb_xcc_id() { return (unsigned)__builtin_amdgcn_s_getreg((3 << 11) | 20) & 0xFu; }
#define XB_SPIN(cond, bar) do { unsigned _sp = 0; while (cond) { __builtin_amdgcn_s_sleep(1); \
    if ((++_sp & 255u) == 0u) { if (xb_ld(&(bar)[XB_TMO])) break; if (_sp > XB_SPIN_CAP) { atomicAdd(&(bar)[XB_TMO], 1u); break; } } } } while (0)

struct XcdBarrier {
    unsigned* bar; unsigned x;
    volatile LAS unsigned* st;
};

__device__ __forceinline__ XcdBarrier xcd_barrier_post(unsigned* bar, volatile LAS unsigned* st) {
    XcdBarrier b; b.bar = bar; b.x = xb_xcc_id(); b.st = st;
    if (threadIdx.x == 0) (void)xb_add(&bar[XB_XCNT(b.x)], 1u);
    return b;
}
__device__ __forceinline__ void xcd_barrier_complete(unsigned* bar, unsigned x, unsigned& nloc, unsigned& nx) {
    const unsigned G = gridDim.x * gridDim.y * gridDim.z;
    unsigned sum, cnt, mine, sp = 0u;
    for (;;) {
        sum = 0u; cnt = 0u; mine = 0u;
#pragma unroll
        for (unsigned j = 0; j < 16; ++j) { const unsigned c = xb_ld(&bar[XB_XCNT(j)]); sum += c; cnt += (c > 0u) ? 1u : 0u; mine = (j == x) ? c : mine; }
        if (sum == G) break;
        __builtin_amdgcn_s_sleep(1);
        if ((++sp & 255u) == 0u) { if (xb_ld(&bar[XB_TMO])) break; if (sp > XB_SPIN_CAP) { atomicAdd(&bar[XB_TMO], 1u); break; } }
    }
    nloc = mine > 0u ? mine : 1u; nx = cnt > 0u ? cnt : 1u;
}

__device__ __forceinline__ void xcd_barrier(const XcdBarrier& b) {
    asm volatile("s_waitcnt vmcnt(0)" ::: "memory");
    __syncthreads();
    if (threadIdx.x == 0) {
        unsigned* bar = b.bar;
        __builtin_amdgcn_s_waitcnt(0);
        unsigned nloc = b.st[0], nx = b.st[1];
        if (nloc == 0u) { xcd_barrier_complete(bar, b.x, nloc, nx); b.st[0] = nloc; b.st[1] = nx; }
        const unsigned old = xb_add(&bar[XB_XSUB(b.x)], 1u);
        const unsigned gen = old / nloc;
        if (old + 1u == (gen + 1u) * nloc) {
            __builtin_amdgcn_fence(__ATOMIC_RELEASE, "agent");
            asm volatile("s_waitcnt vmcnt(0)" ::: "memory");
            const unsigned og = xb_add(&bar[XB_TOP], 1u);
            const unsigned tg = og / nx;
            if (og + 1u == (tg + 1u) * nx) xb_add(&bar[XB_TOPGEN], 1u);
            else XB_SPIN(xb_ld(&bar[XB_TOPGEN]) == tg, bar);
            __builtin_amdgcn_fence(__ATOMIC_ACQUIRE, "agent");
            xb_add(&bar[XB_XGEN(b.x)], 1u);
            asm volatile("s_waitcnt vmcnt(0)" ::: "memory");
        } else {
            XB_SPIN(xb_ld(&bar[XB_XGEN(b.x)]) == gen, bar);
            __builtin_amdgcn_fence(__ATOMIC_ACQUIRE, "agent");
            asm volatile("s_waitcnt vmcnt(0)" ::: "memory");
        }
    }
    __syncthreads();
}

struct Frame {
    LAS unsigned char* lds;
    volatile LAS unsigned* MISC;
    gu32* ctl;
    int tid, lane, wave;
    int vcu, G;
};
__device__ __forceinline__ float bf2f(unsigned short u) { return __builtin_bit_cast(float, (unsigned)u << 16); }
__device__ __forceinline__ float bflo(unsigned w) { return __builtin_bit_cast(float, w << 16); }
__device__ __forceinline__ float bfhi(unsigned w) { return __builtin_bit_cast(float, w & 0xffff0000u); }
__device__ __forceinline__ float wave_sum(float v) {
#pragma unroll
    for (int o = 1; o < 64; o <<= 1) v += __shfl_xor(v, o);
    return v;
}
__device__ __forceinline__ float fexp(float x) { return __builtin_amdgcn_exp2f(x * 1.4426950408889634f); }
__device__ __forceinline__ float sigmoidf_(float z) { return __builtin_amdgcn_rcpf(1.0f + fexp(-z)); }
__device__ __forceinline__ float gelu_tanh(float x) {
    const float z = 0.7978845608028654f * (x + 0.044715f * x * x * x);
    const float t = 1.0f - 2.0f * __builtin_amdgcn_rcpf(fexp(2.0f * z) + 1.0f);
    return 0.5f * x * (1.0f + t);
}
__device__ __constant__ float INV_FREQ[16] = {1.000000000e+00f, 5.623413324e-01f, 3.162277639e-01f, 1.778279394e-01f, 1.000000015e-01f, 5.623412877e-02f, 3.162277862e-02f, 1.778279431e-02f,
                                              9.999999776e-03f, 5.623413250e-03f, 3.162277862e-03f, 1.778279431e-03f, 1.000000047e-03f, 5.623413017e-04f, 3.162277862e-04f, 1.778279402e-04f};

__device__ __forceinline__ void p0_transpose_item(const float* W, int K, int N, bf16* WT, int dst_row0, LAS float* scr, int k0, int n0, int lane) {
#pragma unroll 8
    for (int i = 0; i < 32; ++i) { const int kk = 2 * i + (lane >> 5); scr[kk * 33 + (lane & 31)] = W[(size_t)(k0 + kk) * N + n0 + (lane & 31)]; }
    LDS_WAIT(); asm volatile("" ::: "memory");
    const int c = lane & 7;
#pragma unroll
    for (int j = 0; j < 4; ++j) { const int n = (lane >> 3) + 8 * j; const LAS float* s = scr + (8 * c) * 33 + n;
        v4u o; o.x = pk2(s[0 * 33], s[1 * 33]); o.y = pk2(s[2 * 33], s[3 * 33]); o.z = pk2(s[4 * 33], s[5 * 33]); o.w = pk2(s[6 * 33], s[7 * 33]);
        *(GAS v4u*)(WT + (size_t)(dst_row0 + n) * K + k0 + 8 * c) = o; }
    LDS_WAIT(); asm volatile("" ::: "memory");
}
__device__ __forceinline__ void rms_row_to_bf16(int lane, const float* xrow, const float* g, bf16* orow) {
    const GAS f32x4* xr = (const GAS f32x4*)xrow + lane; const GAS f32x4* gr = (const GAS f32x4*)g + lane;
    f32x4 v[4]; float s = 0.f;
#pragma unroll
    for (int j = 0; j < 4; ++j) { v[j] = xr[64 * j]; s += (v[j].x * v[j].x + v[j].y * v[j].y) + (v[j].z * v[j].z + v[j].w * v[j].w); }
    const float rinv = 1.0f / sqrtf(wave_sum(s) * (1.f / D) + EPS);
    GAS unsigned long long* o8 = (GAS unsigned long long*)orow + lane;
#pragma unroll
    for (int j = 0; j < 4; ++j) { const f32x4 gg = gr[64 * j]; o8[64 * j] = (unsigned long long)pk2(v[j].x * rinv * gg.x, v[j].y * rinv * gg.y) | ((unsigned long long)pk2(v[j].z * rinv * gg.z, v[j].w * rinv * gg.w) << 32); }
}
struct P0Args { const float *x, *g1, *w1g, *w1u, *w1d, *w2g, *w2u, *w2d, *win, *wqb, *wkvb, *wout, *wla, *wlx; unsigned char* ws; };
__device__ __forceinline__ void p0_prologue(Frame& F, const P0Args& a) {
    LAS float* scr = (LAS float*)(F.lds + RING_OFF + F.wave * 16384);
    const int gw = F.vcu * NWAVES + F.wave, NGW = F.G * NWAVES;
    bf16* W1GU = (bf16*)(a.ws + WS_W1GU); bf16* W1D = (bf16*)(a.ws + WS_W1D); bf16* W2GU = (bf16*)(a.ws + WS_W2GU); bf16* W2D = (bf16*)(a.ws + WS_W2D);
    bf16* WIN = (bf16*)(a.ws + WS_WIN); bf16* WQB = (bf16*)(a.ws + WS_WQB); bf16* WKVB = (bf16*)(a.ws + WS_WKVB); bf16* WLRU = (bf16*)(a.ws + WS_WLRU); bf16* WOUT = (bf16*)(a.ws + WS_WOUT);
    constexpr int I_GU = (D / 64) * (FF / 32), I_DN = (FF / 64) * (D / 32), I_IN = (D / 64) * (IN_COLS / 32), I_QB = (QLORA / 64) * (QW / 32), I_KVB = (KVLORA / 64) * (KVW / 32), I_OUT = (D / 64) * (D / 32);
    constexpr int NITEMS = 4 * I_GU + 2 * I_DN + I_IN + I_QB + I_KVB + I_OUT;
    for (int it = gw; it < NITEMS; it += NGW) {
        int r = it;
        if (r < 4 * I_GU) {
            const int which = r / I_GU; r -= which * I_GU; const int nblk = FF / 32, kb = r / nblk, nb = r % nblk, n0 = 32 * nb;
            const float* W = which == 0 ? a.w1g : which == 1 ? a.w1u : which == 2 ? a.w2g : a.w2u; bf16* WT = which < 2 ? W1GU : W2GU;
            p0_transpose_item(W, D, FF, WT, 256 * (n0 / 128) + 128 * (which & 1) + (n0 % 128), scr, 64 * kb, n0, F.lane); continue; }
        r -= 4 * I_GU;
        if (r < 2 * I_DN) { const int which = r / I_DN; r -= which * I_DN; const int nblk = D / 32, kb = r / nblk, nb = r % nblk;
            p0_transpose_item(which ? a.w2d : a.w1d, FF, D, which ? W2D : W1D, 32 * nb, scr, 64 * kb, 32 * nb, F.lane); continue; }
        r -= 2 * I_DN;
        if (r < I_IN) { const int nblk = IN_COLS / 32, kb = r / nblk, nb = r % nblk; p0_transpose_item(a.win, D, IN_COLS, WIN, 32 * nb, scr, 64 * kb, 32 * nb, F.lane); continue; }
        r -= I_IN;
        if (r < I_QB) { const int nblk = QW / 32, kb = r / nblk, nb = r % nblk; p0_transpose_item(a.wqb, QLORA, QW, WQB, 32 * nb, scr, 64 * kb, 32 * nb, F.lane); continue; }
        r -= I_QB;
        if (r < I_KVB) { const int nblk = KVW / 32, kb = r / nblk, nb = r % nblk; p0_transpose_item(a.wkvb, KVLORA, KVW, WKVB, 32 * nb, scr, 64 * kb, 32 * nb, F.lane); continue; }
        r -= I_KVB;
        { const int nblk = D / 32, kb = r / nblk, nb = r % nblk; p0_transpose_item(a.wout, D, D, WOUT, 32 * nb, scr, 64 * kb, 32 * nb, F.lane); }
    }
    { const int gt = (F.vcu * NWAVES + F.wave) * 64 + F.lane, NGT = NGW * 64; GAS unsigned* p = (GAS unsigned*)(WIN + (size_t)IN_COLS * D);
      for (int i = gt; i < (IN_PAD - IN_COLS) * D / 2; i += NGT) p[i] = 0u; }
    { const int gt = (F.vcu * NWAVES + F.wave) * 64 + F.lane, NGT = NGW * 64; GAS unsigned* p = (GAS unsigned*)WLRU;
      for (int i = gt; i < 1024 * 512 / 2; i += NGT) { const int np = i / 256, k = (i % 256) * 2; const int half = np >> 9, c = np & 511, blk = c >> 6, e = c & 63, kb = k >> 6, d = k & 63;
          const float* w = half ? a.wlx : a.wla; unsigned o = 0u; if (kb == blk) o = pk2(w[blk * 4096 + d * 64 + e], w[blk * 4096 + (d + 1) * 64 + e]); p[i] = o; } }
    bf16* XN = (bf16*)(a.ws + WS_XN);
    for (int m = gw; m < M; m += NGW) rms_row_to_bf16(F.lane, a.x + (size_t)m * D, a.g1, XN + (size_t)m * D);
}

__device__ __forceinline__ void rowpass(Frame& F, const float* Fm, const float* base, float* out, const float* g_post, float coef, const float* g_next, bf16* XN) {
    const int gw = F.vcu * NWAVES + F.wave, NGW = F.G * NWAVES, lane = F.lane;
    for (int m = gw; m < M; m += NGW) {
        const GAS f32x4* fr = (const GAS f32x4*)(Fm + (size_t)m * D) + lane; const GAS f32x4* br = (const GAS f32x4*)(base + (size_t)m * D) + lane;
        const GAS f32x4* gp = (const GAS f32x4*)g_post + lane;
        f32x4 v[4], b[4]; float s = 0.f;
#pragma unroll
        for (int j = 0; j < 4; ++j) { v[j] = fr[64 * j]; b[j] = br[64 * j]; s += (v[j].x * v[j].x + v[j].y * v[j].y) + (v[j].z * v[j].z + v[j].w * v[j].w); }
        const float rinv = coef / sqrtf(wave_sum(s) * (1.f / D) + EPS);
        float s2 = 0.f;
#pragma unroll
        for (int j = 0; j < 4; ++j) { const f32x4 gg = gp[64 * j]; v[j] = b[j] + v[j] * rinv * gg; s2 += (v[j].x * v[j].x + v[j].y * v[j].y) + (v[j].z * v[j].z + v[j].w * v[j].w); }
        GAS f32x4* orow = (GAS f32x4*)(out + (size_t)m * D) + lane;
#pragma unroll
        for (int j = 0; j < 4; ++j) orow[64 * j] = v[j];
        if (XN) {
            const float r2 = 1.0f / sqrtf(wave_sum(s2) * (1.f / D) + EPS); const GAS f32x4* gn = (const GAS f32x4*)g_next + lane;
            GAS unsigned long long* o8 = (GAS unsigned long long*)(XN + (size_t)m * D) + lane;
#pragma unroll
            for (int j = 0; j < 4; ++j) { const f32x4 gg = gn[64 * j]; o8[64 * j] = (unsigned long long)pk2(v[j].x * r2 * gg.x, v[j].y * r2 * gg.y) | ((unsigned long long)pk2(v[j].z * r2 * gg.z, v[j].w * r2 * gg.w) << 32); }
        }
    }
}

struct PrepArgs { const int* pos; const float *gq, *gkv, *cw, *cb; unsigned char* ws; };
__device__ __forceinline__ void prep_pass(Frame& F, const PrepArgs& a) {
    const int gw = F.vcu * NWAVES + F.wave, NGW = F.G * NWAVES, lane = F.lane;
    const bf16* PROJ = (const bf16*)(a.ws + WS_PROJ); bf16* QLN = (bf16*)(a.ws + WS_QLN); bf16* KVLN = (bf16*)(a.ws + WS_KVLN); bf16* KPE = (bf16*)(a.ws + WS_KPE);
    float* COS = (float*)(a.ws + WS_COS); float* SIN = (float*)(a.ws + WS_SIN); bf16* XC = (bf16*)(a.ws + WS_XC);
    for (int m = gw; m < M; m += NGW) {
        const bf16* pr = PROJ + (size_t)m * IN_PAD;
        {
            const GAS unsigned* p = (const GAS unsigned*)(pr + C_QLAT + lane * 6); const unsigned w0 = p[0], w1 = p[1], w2 = p[2];
            float v[6] = {bflo(w0), bfhi(w0), bflo(w1), bfhi(w1), bflo(w2), bfhi(w2)}; float s = 0.f;
#pragma unroll
            for (int j = 0; j < 6; ++j) s += v[j] * v[j];
            const float rinv = 1.0f / sqrtf(wave_sum(s) * (1.f / QLORA) + EPS); const float* g = a.gq + lane * 6;
            GAS unsigned* o = (GAS unsigned*)(QLN + (size_t)m * QLORA + lane * 6);
            o[0] = pk2(v[0] * rinv * g[0], v[1] * rinv * g[1]); o[1] = pk2(v[2] * rinv * g[2], v[3] * rinv * g[3]); o[2] = pk2(v[4] * rinv * g[4], v[5] * rinv * g[5]);
        }
        {
            const GAS unsigned* p = (const GAS unsigned*)(pr + C_KVLAT + lane * 4); const unsigned w0 = p[0], w1 = p[1];
            float v[4] = {bflo(w0), bfhi(w0), bflo(w1), bfhi(w1)}; float s = (v[0] * v[0] + v[1] * v[1]) + (v[2] * v[2] + v[3] * v[3]);
            const float rinv = 1.0f / sqrtf(wave_sum(s) * (1.f / KVLORA) + EPS); const float* g = a.gkv + lane * 4;
            GAS unsigned* o = (GAS unsigned*)(KVLN + (size_t)m * KVLORA + lane * 4);
            o[0] = pk2(v[0] * rinv * g[0], v[1] * rinv * g[1]); o[1] = pk2(v[2] * rinv * g[2], v[3] * rinv * g[3]);
        }
        if (lane < 16) {
            const float x1 = bf2f(pr[C_KROPE + lane]), x2 = bf2f(pr[C_KROPE + 16 + lane]);
            const float ang = (float)a.pos[m] * INV_FREQ[lane];
            double rev = (double)ang * 0.15915494309189535; rev -= __builtin_rint(rev); const float fr = (float)rev;
            const float sn = __builtin_amdgcn_sinf(fr), cs = __builtin_amdgcn_cosf(fr);
            KPE[(size_t)m * 32 + lane] = (bf16)f2bf(x1 * cs - x2 * sn); KPE[(size_t)m * 32 + 16 + lane] = (bf16)f2bf(x2 * cs + x1 * sn);
            COS[(size_t)m * 16 + lane] = cs; SIN[(size_t)m * 16 + lane] = sn;
        }
        {
            const int t = m % SEQ; float acc[8];
#pragma unroll
            for (int j = 0; j < 8; ++j) acc[j] = a.cb[lane * 8 + j];
#pragma unroll
            for (int k = 0; k < 4; ++k) { const int tt = t - 3 + k; if (tt >= 0) {
                const v4u w = *(const GAS v4u*)(PROJ + (size_t)(m - 3 + k) * IN_PAD + lane * 8); const float* cwk = a.cw + k * LRU_W + lane * 8;
                acc[0] += cwk[0] * bflo(w.x); acc[1] += cwk[1] * bfhi(w.x); acc[2] += cwk[2] * bflo(w.y); acc[3] += cwk[3] * bfhi(w.y);
                acc[4] += cwk[4] * bflo(w.z); acc[5] += cwk[5] * bfhi(w.z); acc[6] += cwk[6] * bflo(w.w); acc[7] += cwk[7] * bfhi(w.w); } }
            v4u o; o.x = pk2(acc[0], acc[1]); o.y = pk2(acc[2], acc[3]); o.z = pk2(acc[4], acc[5]); o.w = pk2(acc[6], acc[7]);
            *(GAS v4u*)(XC + (size_t)m * LRU_W + lane * 8) = o;
        }
    }
}

__device__ __forceinline__ void qrope_pass(Frame& F, unsigned char* ws) {
    const int gw = F.vcu * NWAVES + F.wave, NGW = F.G * NWAVES, lane = F.lane;
    bf16* Q = (bf16*)(ws + WS_Q); const float* COS = (const float*)(ws + WS_COS); const float* SIN = (const float*)(ws + WS_SIN);
    for (int m = gw; m < M; m += NGW) {
        bf16* q = Q + (size_t)m * QW;
#pragma unroll
        for (int pp = 0; pp < 2; ++pp) { const int p = lane + 64 * pp, h = p >> 4, i = p & 15; bf16* qa = q + h * 96 + 64 + i;
            const float x1 = bf2f(qa[0]), x2 = bf2f(qa[16]); const float cs = COS[(size_t)m * 16 + i], sn = SIN[(size_t)m * 16 + i];
            qa[0] = (bf16)f2bf((x1 * cs - x2 * sn) * QSCALE); qa[16] = (bf16)f2bf((x2 * cs + x1 * sn) * QSCALE); }
        {
            GAS v4u* p = (GAS v4u*)(q + (lane >> 3) * 96 + (lane & 7) * 8); const v4u w = *p; v4u o;
            o.x = pk2(bflo(w.x) * QSCALE, bfhi(w.x) * QSCALE); o.y = pk2(bflo(w.y) * QSCALE, bfhi(w.y) * QSCALE); o.z = pk2(bflo(w.z) * QSCALE, bfhi(w.z) * QSCALE); o.w = pk2(bflo(w.w) * QSCALE, bfhi(w.w) * QSCALE);
            *p = o; }
    }
}

struct LruCh { float ba, bx, sp8; };
__device__ __forceinline__ LruCh lru_channel(const float* ba, const float* bx, const float* lam, int c) {
    LruCh r; r.ba = ba[c]; r.bx = bx[c]; const float y = fexp(-lam[c]);
    const float sp = (y > 0.05f) ? __logf(1.0f + y) : y * (1.0f + y * (-0.5f + y * (0.33333333f + y * (-0.25f + y * 0.2f))));
    r.sp8 = 8.0f * sp; return r;
}
__device__ __forceinline__ void lru_au(const LruCh& ch, float rpre, float ipre, float xc, float& a, float& u) {
    const float r = sigmoidf_(rpre + ch.ba), ig = sigmoidf_(ipre + ch.bx);
    const float la = -ch.sp8 * r; a = fexp(la);
    const float x = 2.0f * la;
    const float em = (x > -0.25f) ? -x * (1.0f + x * (0.5f + x * (0.16666667f + x * (0.041666667f + x * (0.0083333333f + x * 0.0013888889f))))) : 1.0f - fexp(x);
    u = sqrtf(em) * (ig * xc);
}
struct ScanArgs { const float *ba, *bx, *lam; unsigned char* ws; };
__device__ __forceinline__ void scan_pass1(Frame& F, const ScanArgs& a) {
    const bf16* GATES = (const bf16*)(a.ws + WS_GATES); const bf16* XC = (const bf16*)(a.ws + WS_XC); float* AGG = (float*)(a.ws + WS_AGG);
    const int c = F.tid; const LruCh ch = lru_channel(a.ba, a.bx, a.lam, c);
    for (int cu = F.vcu; cu < BATCH * NCHUNK; cu += F.G) {
        const size_t row0 = (size_t)cu * 64; float A = 1.0f, H = 0.0f;
#pragma unroll 8
        for (int t = 0; t < 64; ++t) { const size_t r = row0 + t; float av, uv;
            lru_au(ch, bf2f(GATES[r * 1024 + c]), bf2f(GATES[r * 1024 + 512 + c]), bf2f(XC[r * LRU_W + c]), av, uv);
            A *= av; H = av * H + uv; }
        AGG[((size_t)cu * LRU_W + c) * 2] = A; AGG[((size_t)cu * LRU_W + c) * 2 + 1] = H;
    }
}
__device__ __forceinline__ void scan_pass2(Frame& F, const ScanArgs& a) {
    const bf16* GATES = (const bf16*)(a.ws + WS_GATES); const bf16* XC = (const bf16*)(a.ws + WS_XC); const float* AGG = (const float*)(a.ws + WS_AGG);
    const bf16* PROJ = (const bf16*)(a.ws + WS_PROJ); bf16* Y = (bf16*)(a.ws + WS_Y);
    const int c = F.tid; const LruCh ch = lru_channel(a.ba, a.bx, a.lam, c);
    for (int cu = F.vcu; cu < BATCH * NCHUNK; cu += F.G) {
        const int b = cu / NCHUNK, ci = cu % NCHUNK; float h = 0.0f;
        for (int j = 0; j < ci; ++j) { const size_t o = ((size_t)(b * NCHUNK + j) * LRU_W + c) * 2; h = AGG[o] * h + AGG[o + 1]; }
        const size_t row0 = (size_t)cu * 64;
#pragma unroll 8
        for (int t = 0; t < 64; ++t) { const size_t r = row0 + t; float av, uv;
            lru_au(ch, bf2f(GATES[r * 1024 + c]), bf2f(GATES[r * 1024 + 512 + c]), bf2f(XC[r * LRU_W + c]), av, uv);
            h = av * h + uv; const float g = bf2f(PROJ[r * IN_PAD + LRU_W + c]);
            Y[r * D + c] = (bf16)f2bf(h * gelu_tanh(g)); }
    }
}

__device__ __forceinline__ void attn_naive(Frame& F, unsigned char* ws) {
    const bf16* Q = (const bf16*)(ws + WS_Q); const bf16* KV = (const bf16*)(ws + WS_KV); const bf16* KPE = (const bf16*)(ws + WS_KPE); bf16* Y = (bf16*)(ws + WS_Y);
    for (int u = F.vcu; u < 512; u += F.G) {
        const int uu = u & 255, bh = uu >> 2, qb = (u < 256) ? (uu & 3) : 7 - (uu & 3); const int b = bh >> 3, h = bh & 7;
        const int t = qb * 512 + F.tid; const size_t row = (size_t)b * SEQ + t;
        float q[96], o[64];
        { const GAS v4u* qp = (const GAS v4u*)(Q + row * QW + h * 96);
#pragma unroll
          for (int j = 0; j < 12; ++j) { const v4u w = qp[j]; q[8 * j] = bflo(w.x); q[8 * j + 1] = bfhi(w.x); q[8 * j + 2] = bflo(w.y); q[8 * j + 3] = bfhi(w.y); q[8 * j + 4] = bflo(w.z); q[8 * j + 5] = bfhi(w.z); q[8 * j + 6] = bflo(w.w); q[8 * j + 7] = bfhi(w.w); } }
#pragma unroll
        for (int d = 0; d < 64; ++d) o[d] = 0.f;
        float mx = -1e30f, l = 0.f;
        const int nk = __builtin_amdgcn_readfirstlane(((t >> 6) + 1) << 6);
        for (int j = 0; j < nk; ++j) {
            const size_t kr = (size_t)b * SEQ + j; const GAS v4u* kn = (const GAS v4u*)(KV + kr * KVW + h * 128); const GAS v4u* kp = (const GAS v4u*)(KPE + kr * 32);
            float s = 0.f;
#pragma unroll
            for (int jj = 0; jj < 8; ++jj) { const v4u w = kn[jj]; s += q[8 * jj] * bflo(w.x) + q[8 * jj + 1] * bfhi(w.x) + q[8 * jj + 2] * bflo(w.y) + q[8 * jj + 3] * bfhi(w.y) + q[8 * jj + 4] * bflo(w.z) + q[8 * jj + 5] * bfhi(w.z) + q[8 * jj + 6] * bflo(w.w) + q[8 * jj + 7] * bfhi(w.w); }
#pragma unroll
            for (int jj = 0; jj < 4; ++jj) { const v4u w = kp[jj]; s += q[64 + 8 * jj] * bflo(w.x) + q[64 + 8 * jj + 1] * bfhi(w.x) + q[64 + 8 * jj + 2] * bflo(w.y) + q[64 + 8 * jj + 3] * bfhi(w.y) + q[64 + 8 * jj + 4] * bflo(w.z) + q[64 + 8 * jj + 5] * bfhi(w.z) + q[64 + 8 * jj + 6] * bflo(w.w) + q[64 + 8 * jj + 7] * bfhi(w.w); }
            const float mn = fmaxf(mx, s), al = __builtin_amdgcn_exp2f(mx - mn), p = __builtin_amdgcn_exp2f(s - mn); mx = mn; l = l * al + p;
#pragma unroll
            for (int jj = 0; jj < 8; ++jj) { const v4u w = kn[8 + jj];
                o[8 * jj] = o[8 * jj] * al + p * bflo(w.x); o[8 * jj + 1] = o[8 * jj + 1] * al + p * bfhi(w.x); o[8 * jj + 2] = o[8 * jj + 2] * al + p * bflo(w.y); o[8 * jj + 3] = o[8 * jj + 3] * al + p * bfhi(w.y);
                o[8 * jj + 4] = o[8 * jj + 4] * al + p * bflo(w.z); o[8 * jj + 5] = o[8 * jj + 5] * al + p * bfhi(w.z); o[8 * jj + 6] = o[8 * jj + 6] * al + p * bflo(w.w); o[8 * jj + 7] = o[8 * jj + 7] * al + p * bfhi(w.w); }
        }
        const float rl = 1.0f / l; GAS v4u* yp = (GAS v4u*)(Y + row * D + 512 + h * 64);
#pragma unroll
        for (int jj = 0; jj < 8; ++jj) { v4u w; w.x = pk2(o[8 * jj] * rl, o[8 * jj + 1] * rl); w.y = pk2(o[8 * jj + 2] * rl, o[8 * jj + 3] * rl); w.z = pk2(o[8 * jj + 4] * rl, o[8 * jj + 5] * rl); w.w = pk2(o[8 * jj + 6] * rl, o[8 * jj + 7] * rl); yp[jj] = w; }
    }
}

struct Args { const float* in[27]; float* out; unsigned char* ws; int ph_lo, ph_hi, li, pad; };
__global__ void __launch_bounds__(NWAVES * 64, 2) mega_fwd(Args args) {
    extern __shared__ __attribute__((aligned(16))) unsigned char lds[];
    Frame F;
    F.lds = (LAS unsigned char*)lds;
    F.MISC = (volatile LAS unsigned*)(F.lds + MISC_OFF);
    F.tid = threadIdx.x; F.lane = F.tid & 63; F.wave = __builtin_amdgcn_readfirstlane(F.tid >> 6);
    F.G = gridDim.x; { const int bx = blockIdx.x; F.vcu = (F.G % 8 == 0) ? (bx % 8) * (F.G / 8) + bx / 8 : bx; }
    unsigned char* ws = args.ws;
    F.ctl = (gu32*)(ws + WS_CTL);
    for (int u = F.tid; u < (LDS_BYTES - LDSCTL_OFF) / 4; u += NWAVES * 64) ((LAS unsigned*)(F.lds + LDSCTL_OFF))[u] = 0u;
    __syncthreads();
    XcdBarrier bar; bar.bar = (unsigned*)(F.ctl + CW_BAR); bar.x = 0; bar.st = nullptr;
    const int lo = args.ph_lo, hi = args.ph_hi;
    if (hi - lo > 1) bar = xcd_barrier_post((unsigned*)(F.ctl + CW_BAR), F.MISC + 8);

    const float* x = args.in[0]; const int* pos = (const int*)args.in[1];
    bf16* XN = (bf16*)(ws + WS_XN); bf16* HB = (bf16*)(ws + WS_HB); float* Fm = (float*)(ws + WS_F); bf16* Y = (bf16*)(ws + WS_Y);
    bf16* PROJ = (bf16*)(ws + WS_PROJ); bf16* GATES = (bf16*)(ws + WS_GATES); bf16* Qb = (bf16*)(ws + WS_Q); bf16* KVb = (bf16*)(ws + WS_KV);

#define IN(k) (lo <= (k) && (k) < hi)
#define SEAM(k) do { if (IN(k) && IN((k) + 1)) { xcd_barrier(bar); } } while (0)
#define GEMM_SWIGLU(WOFF) do { pg8::Gemm g{XN, (const bf16*)(ws + (WOFF)), M, 2 * FF, D}; pg8::StaticOrder S; S.init(M, 2 * FF, F.G, (int)blockIdx.x); pg8::EpiSwiglu E{HB, FF}; \
        pg8::gemm_phase<pg8::EpiSwiglu, pg8::StaticOrder, PG8_ALIGN, PG8_SP2>(F.lds + RING_OFF, g, S, E); } while (0)
#define GEMM_F32(A_, WOFF, K_) do { pg8::Gemm g{(A_), (const bf16*)(ws + (WOFF)), M, D, (K_)}; pg8::StaticOrder S; S.init(M, D, F.G, (int)blockIdx.x); pg8::EpiF32 E{Fm, D}; \
        pg8::gemm_phase<pg8::EpiF32, pg8::StaticOrder, PG8_ALIGN, PG8_SP2>(F.lds + RING_OFF, g, S, E); } while (0)
#define GEMM_BF16(A_, WOFF, N_, K_, O_) do { pg8::Gemm g{(A_), (const bf16*)(ws + (WOFF)), M, (N_), (K_)}; pg8::StaticOrder S; S.init(M, (N_), F.G, (int)blockIdx.x); pg8::EpiBf16 E{(O_), (N_)}; \
        pg8::gemm_phase<pg8::EpiBf16, pg8::StaticOrder, PG8_ALIGN, PG8_SP2>(F.lds + RING_OFF, g, S, E); } while (0)
    if (IN(0)) { P0Args a{x, args.in[2], args.in[4], args.in[5], args.in[6], args.in[24], args.in[25], args.in[26], args.in[9], args.in[18], args.in[20], args.in[21], args.in[12], args.in[14], ws}; p0_prologue(F, a); }
    SEAM(0);
    if (IN(1)) GEMM_SWIGLU(WS_W1GU);
    SEAM(1);
    if (IN(2)) GEMM_F32(HB, WS_W1D, FF);
    SEAM(2);
    if (IN(3)) rowpass(F, Fm, x, args.out, args.in[3], 0.5f, args.in[7], XN);
    SEAM(3);
    if (IN(4)) GEMM_BF16(XN, WS_WIN, IN_PAD, D, PROJ);
    SEAM(4);
    if (IN(5)) { PrepArgs a{pos, args.in[17], args.in[19], args.in[10], args.in[11], ws}; prep_pass(F, a); }
    SEAM(5);
    if (IN(6)) { GEMM_BF16((const bf16*)(ws + WS_QLN), WS_WQB, QW, QLORA, Qb); GEMM_BF16((const bf16*)(ws + WS_KVLN), WS_WKVB, KVW, KVLORA, KVb); GEMM_BF16((const bf16*)(ws + WS_XC), WS_WLRU, 1024, LRU_W, GATES); }
    SEAM(6);
    if (IN(7)) { qrope_pass(F, ws); ScanArgs a{args.in[13], args.in[15], args.in[16], ws}; scan_pass1(F, a); }
    SEAM(7);
    if (IN(8)) { ScanArgs a{args.in[13], args.in[15], args.in[16], ws}; scan_pass2(F, a); attn_naive(F, ws); }
    SEAM(8);
    if (IN(9)) GEMM_F32(Y, WS_WOUT, D);
    SEAM(9);
    if (IN(10)) rowpass(F, Fm, args.out, args.out, args.in[8], 1.0f, args.in[22], XN);
    SEAM(10);
    if (IN(11)) GEMM_SWIGLU(WS_W2GU);
    SEAM(11);
    if (IN(12)) GEMM_F32(HB, WS_W2D, FF);
    SEAM(12);
    if (IN(13)) rowpass(F, Fm, args.out, args.out, args.in[23], 0.5f, nullptr, nullptr);
#undef IN
#undef SEAM
}

extern "C" void kernel_launch(void* const* d_in, const int* in_sizes, int n_in, void* d_out, int out_size, void* d_ws, size_t ws_size, hipStream_t stream) {
    static int grid = 0;
    if (grid == 0) {
        if (n_in != 27 || in_sizes[0] != M * D || out_size != M * D || ws_size < WS_END) { fprintf(stderr, "kernel_launch: unexpected shapes: n_in %d in0 %d out %d ws %zu (need %zu); nothing launched\n", n_in, n_in > 0 ? in_sizes[0] : -1, out_size, ws_size, (size_t)WS_END); grid = -1; return; }
        int dev = 0, cus = 0, per_cu = 0;
        if (hipGetDevice(&dev) != hipSuccess || hipDeviceGetAttribute(&cus, hipDeviceAttributeMultiprocessorCount, dev) != hipSuccess) { fprintf(stderr, "kernel_launch: device query failed\n"); grid = -1; return; }
        if (hipFuncSetAttribute((const void*)mega_fwd, hipFuncAttributeMaxDynamicSharedMemorySize, LDS_BYTES) != hipSuccess) { fprintf(stderr, "kernel_launch: hipFuncSetAttribute failed\n"); grid = -1; return; }
        if (hipOccupancyMaxActiveBlocksPerMultiprocessor(&per_cu, (const void*)mega_fwd, NWAVES * 64, LDS_BYTES) != hipSuccess || per_cu < 1)
            fprintf(stderr, "kernel_launch: note: occupancy query reports %d workgroups per CU\n", per_cu);
        (void)hipGetLastError();
        grid = cus;
    }
    if (grid < 0) return;
    if (hipMemsetAsync((char*)d_ws + WS_CTL, 0, CTL_ZERO_BYTES, stream) != hipSuccess) { fprintf(stderr, "kernel_launch: hipMemsetAsync failed\n"); return; }
    Args a{};
    for (int i = 0; i < 27; ++i) a.in[i] = (const float*)d_in[i];
    a.out = (float*)d_out; a.ws = (unsigned char*)d_ws;
#if MK_ONE_LAUNCH
    a.ph_lo = 0; a.ph_hi = N_PHASES; a.li = 0;
    hipLaunchKernelGGL(mega_fwd, dim3(grid), dim3(NWAVES * 64), LDS_BYTES, stream, a);
#else
    for (int li = 0; li < N_PHASES; ++li) { a.ph_lo = li; a.ph_hi = li + 1; a.li = li;
        hipLaunchKernelGGL(mega_fwd, dim3(grid), dim3(NWAVES * 64), LDS_BYTES, stream, a); }
#endif
    const hipError_t le = hipPeekAtLastError();
    if (le != hipSuccess) fprintf(stderr, "kernel_launch: launch failed: %s\n", hipGetErrorName(le));
}
```

```cpp
#include <hip/hip_runtime.h>
#include <cstdio>
#include <cstdint>
namespace pg8 {
#define PG8_LAS __attribute__((address_space(3)))
typedef unsigned short bf16_t;
typedef short bf16x8 __attribute__((ext_vector_type(8)));
typedef float f32x4 __attribute__((ext_vector_type(4)));
typedef unsigned u32x4 __attribute__((ext_vector_type(4)));
constexpr int BM = 256, BK = 64, HALF = 128, HTB = HALF * BK * 2  , STAGE_BYTES = 8 * HTB, NXCD = 8, WGM = 8;

__host__ __device__ __forceinline__ int lds_byte(int r, int c) { const int st = (r >> 4) * 2 + (c >> 5), rr = r & 15, cc = c & 31, ob = rr * 64 + cc * 2; return st * 1024 + (ob ^ (((ob >> 9) & 1) << 5)); }
__host__ __device__ __forceinline__ void stage_rc(int b, int& R, int& C) { const int st = b / 1024, sb = b % 1024, swz = sb ^ (((sb >> 9) & 1) << 5); R = (st >> 1) * 16 + swz / 64; C = (st & 1) * 32 + (swz % 64) / 2; }
__host__ __device__ __forceinline__ int perm32(int rho) { const int n = rho >> 4, i = rho & 15; return 8 * (i >> 2) + 4 * n + (i & 3); }

struct Unit { int pm, pn; };
struct Gemm { const bf16_t* A; const bf16_t* Bt; int M, N, K; };

struct StaticOrder {
    int nM, nN, nwg, G, c;
    __host__ __device__ void init(int M, int N, int G_, int c_) { nM = M / BM; nN = N / BM; nwg = nM * nN; G = G_; c = c_; }
    __host__ __device__ bool next(int i, Unit& u) const {
        const long L = (long)i * G + c; if (L >= nwg) return false;
        int wgid = (int)L; { const int q = nwg / NXCD, r = nwg % NXCD, xcd = wgid % NXCD, off = wgid / NXCD; wgid = (xcd < r ? xcd * (q + 1) : r * (q + 1) + (xcd - r) * q) + off; }
        const int nig = WGM * nN, gid = wgid / nig, fm = gid * WGM, gsz = (nM - fm) < WGM ? (nM - fm) : WGM;
        u.pm = fm + ((wgid % nig) % gsz); u.pn = (wgid % nig) / gsz; return true;
    }
    __device__ __forceinline__ void a_ready(const Unit&) const {}
    __device__ __forceinline__ void done(const Unit&) const {}
};

__device__ __forceinline__ unsigned cvt_pk_bf16(float lo, float hi) { unsigned r; asm volatile("v_cvt_pk_bf16_f32 %0, %1, %2" : "=v"(r) : "v"(lo), "v"(hi)); return r; }

struct EpiBf16 {
    static constexpr bool PERM = true, AFTER_DRAIN = false;
    bf16_t* O; int ldc;
    __device__ __forceinline__ void operator()(const f32x4 (&acc)[2][2][4][2], const Unit& u, int wr, int wc, int fr, int fq) const {
        const int row0 = u.pm * BM + wr * 64 + fr, col0 = u.pn * BM + wc * 32 + 8 * fq;
#pragma unroll
        for (int ai = 0; ai < 2; ++ai)
#pragma unroll
            for (int m = 0; m < 4; ++m) { bf16_t* rowp = O + (size_t)(row0 + ai * HALF + m * 16) * ldc + col0;
#pragma unroll
                for (int bj = 0; bj < 2; ++bj) { const f32x4 v0 = acc[ai][bj][m][0], v1 = acc[ai][bj][m][1];
                    u32x4 w; w.x = cvt_pk_bf16(v0[0], v0[1]); w.y = cvt_pk_bf16(v0[2], v0[3]); w.z = cvt_pk_bf16(v1[0], v1[1]); w.w = cvt_pk_bf16(v1[2], v1[3]);
                    *(u32x4*)(rowp + bj * HALF) = w; } }
    }
};
__device__ __forceinline__ float silu_mul(float g, float u) { return g * __builtin_amdgcn_rcpf(1.0f + __builtin_amdgcn_exp2f(-1.4426950408889634f * g)) * u; }
struct EpiSwiglu {
    static constexpr bool PERM = true, AFTER_DRAIN = false;
    bf16_t* O; int ldc;
    __device__ __forceinline__ void operator()(const f32x4 (&acc)[2][2][4][2], const Unit& u, int wr, int wc, int fr, int fq) const {
        const int row0 = u.pm * BM + wr * 64 + fr, col0 = u.pn * HALF + wc * 32 + 8 * fq;
#pragma unroll
        for (int ai = 0; ai < 2; ++ai)
#pragma unroll
            for (int m = 0; m < 4; ++m) { bf16_t* rowp = O + (size_t)(row0 + ai * HALF + m * 16) * ldc + col0;
                const f32x4 g0 = acc[ai][0][m][0], g1 = acc[ai][0][m][1], u0 = acc[ai][1][m][0], u1 = acc[ai][1][m][1];
                u32x4 w; w.x = cvt_pk_bf16(silu_mul(g0[0], u0[0]), silu_mul(g0[1], u0[1])); w.y = cvt_pk_bf16(silu_mul(g0[2], u0[2]), silu_mul(g0[3], u0[3]));
                w.z = cvt_pk_bf16(silu_mul(g1[0], u1[0]), silu_mul(g1[1], u1[1])); w.w = cvt_pk_bf16(silu_mul(g1[2], u1[2]), silu_mul(g1[3], u1[3]));
                *(u32x4*)rowp = w; }
    }
};
struct EpiF32 {
    static constexpr bool PERM = false, AFTER_DRAIN = false;
    float* C; int ldc;
    __device__ __forceinline__ void operator()(const f32x4 (&acc)[2][2][4][2], const Unit& u, int wr, int wc, int fr, int fq) const {
        const int row0 = u.pm * BM + wr * 64 + fr, col0 = u.pn * BM + wc * 32 + 4 * fq;
#pragma unroll
        for (int ai = 0; ai < 2; ++ai)
#pragma unroll
            for (int m = 0; m < 4; ++m) { float* rowp = C + (size_t)(row0 + ai * HALF + m * 16) * ldc + col0;
#pragma unroll
                for (int bj = 0; bj < 2; ++bj)
#pragma unroll
                    for (int n = 0; n < 2; ++n) *(f32x4*)(rowp + bj * HALF + n * 16) = acc[ai][bj][m][n]; }
    }
};

template <class Epi, class Sched, bool ALIGN_EPI = false, bool SP2 = false>
__device__ __forceinline__ void gemm_phase(PG8_LAS unsigned char* lds, const Gemm g, const Sched& S, const Epi& E) {
    const int tid = threadIdx.x, wid = __builtin_amdgcn_readfirstlane(tid >> 6), lane = tid & 63, wr = wid >> 2, wc = wid & 3, fr = lane & 15, fq = lane >> 4;
    const int K = g.K, nt = K / BK;
    unsigned voffA[2], voffB[2];
#pragma unroll
    for (int i = 0; i < 2; ++i) { int R, C; stage_rc(tid * 16 + i * 8192, R, C); const int Rb = Epi::PERM ? ((R & ~31) + perm32(R & 31)) : R;
        voffA[i] = (unsigned)(R * K + C) * 2u; voffB[i] = (unsigned)(Rb * K + C) * 2u; }
    const size_t kstep = (size_t)(BK * 2);
    const size_t hstep = (size_t)HALF * K * 2;
    const size_t tstep = 2 * hstep;
    const unsigned ldsw = (unsigned)wid * 1024u;
    const int aoff = lds_byte(wr * 64 + fr, fq * 8), boff = lds_byte(wc * 32 + fr, fq * 8);
#define PG8_SA(b, h) (((b) * 2 + (h)) * HTB)
#define PG8_SB(b, h) ((4 + (b) * 2 + (h)) * HTB)
#define PG8_STAGE(bufoff, gbase, voff) do { _Pragma("unroll") for (int _i = 0; _i < 2; ++_i) \
        __builtin_amdgcn_global_load_lds((const unsigned*)((const char*)(gbase) + (voff)[_i]), (PG8_LAS unsigned*)(lds + (bufoff) + ldsw + _i * 8192), 16, 0, 0); } while (0)
#define PG8_LDA(dst, b, h) do { _Pragma("unroll") for (int m = 0; m < 4; ++m) _Pragma("unroll") for (int k = 0; k < 2; ++k) dst[m][k] = *(const PG8_LAS bf16x8*)(lds + PG8_SA(b, h) + aoff + m * 2048 + k * 1024); } while (0)
#define PG8_LDB(dst, b, h) do { _Pragma("unroll") for (int n = 0; n < 2; ++n) _Pragma("unroll") for (int k = 0; k < 2; ++k) dst[n][k] = *(const PG8_LAS bf16x8*)(lds + PG8_SB(b, h) + boff + n * 2048 + k * 1024); } while (0)
#define PG8_MMA(ai, bj, At, Bt) do { __builtin_amdgcn_s_setprio(1); _Pragma("unroll") for (int m = 0; m < 4; ++m) _Pragma("unroll") for (int n = 0; n < 2; ++n) _Pragma("unroll") for (int k = 0; k < 2; ++k) \
        acc[ai][bj][m][n] = __builtin_amdgcn_mfma_f32_16x16x32_bf16(Bt[n][k], At[m][k], acc[ai][bj][m][n], 0, 0, 0); __builtin_amdgcn_s_setprio(0); } while (0)
#define PG8_WAIT_V(n) asm volatile("s_waitcnt vmcnt(" #n ")" ::: "memory")
#define PG8_WAIT_L(n) asm volatile("s_waitcnt lgkmcnt(" #n ")" ::: "memory")
#define PG8_BAR __builtin_amdgcn_s_barrier()
#define PG8_SCHED __builtin_amdgcn_sched_barrier(0)
    Unit cur, nxt; int ui = 0;
    if (!S.next(0, cur)) return;
    f32x4 acc[2][2][4][2];
#pragma unroll
    for (int a = 0; a < 2; ++a)
#pragma unroll
        for (int b = 0; b < 2; ++b)
#pragma unroll
            for (int m = 0; m < 4; ++m)
#pragma unroll
                for (int n = 0; n < 2; ++n) acc[a][b][m][n] = (f32x4){0.f, 0.f, 0.f, 0.f};
    bf16x8 At[4][2], B0[2][2], B1[2][2];
    const char* cA = (const char*)g.A + (size_t)cur.pm * tstep; const char* cB = (const char*)g.Bt + (size_t)cur.pn * tstep;
    S.a_ready(cur);
    if constexpr (SP2) {
        PG8_STAGE(PG8_SB(0, 0), cB, voffB); PG8_STAGE(PG8_SB(0, 1), cB + hstep, voffB); PG8_STAGE(PG8_SA(0, 0), cA, voffA); PG8_STAGE(PG8_SA(0, 1), cA + hstep, voffA);
        if (wr == 1) PG8_BAR;
        PG8_WAIT_V(2); PG8_BAR;
        PG8_STAGE(PG8_SB(1, 0), cB + kstep, voffB); PG8_STAGE(PG8_SA(1, 0), cA + kstep, voffA); PG8_STAGE(PG8_SB(1, 1), cB + hstep + kstep, voffB);
        PG8_WAIT_V(6); PG8_BAR;
    } else {
        PG8_STAGE(PG8_SB(0, 0), cB, voffB); PG8_STAGE(PG8_SA(0, 0), cA, voffA); PG8_STAGE(PG8_SB(0, 1), cB + hstep, voffB); PG8_STAGE(PG8_SA(0, 1), cA + hstep, voffA);
        if (wr == 1) PG8_BAR;
        PG8_WAIT_V(4); PG8_BAR;
        PG8_STAGE(PG8_SB(1, 0), cB + kstep, voffB); PG8_STAGE(PG8_SA(1, 0), cA + kstep, voffA); PG8_STAGE(PG8_SB(1, 1), cB + hstep + kstep, voffB);
        PG8_WAIT_V(6); PG8_BAR;
    }
    for (;;) {
        const bool has_next = S.next(ui + 1, nxt);
        const char* nA = has_next ? (const char*)g.A + (size_t)nxt.pm * tstep : cA; const char* nB = has_next ? (const char*)g.Bt + (size_t)nxt.pn * tstep : cB;
        for (int t = 0; t < nt; t += 2) {
            const bool last = (t == nt - 2);
            const char* a1 = cA + (size_t)(t + 1) * kstep;
            const char* a2 = last ? nA : cA + (size_t)(t + 2) * kstep; const char* b2 = last ? nB : cB + (size_t)(t + 2) * kstep;
            const char* a3 = a2 + kstep; const char* b3 = b2 + kstep;
            if (last && has_next) S.a_ready(nxt);
            if constexpr (SP2) {
            PG8_LDB(B0, 0, 0); PG8_LDB(B1, 0, 1); PG8_SCHED; PG8_LDA(At, 0, 0); PG8_STAGE(PG8_SA(1, 1), a1 + hstep, voffA);
            PG8_WAIT_V(8); PG8_WAIT_L(0); PG8_BAR; PG8_MMA(0, 0, At, B0); PG8_MMA(0, 1, At, B1); PG8_BAR; PG8_SCHED;
            PG8_LDA(At, 0, 1); PG8_STAGE(PG8_SB(0, 0), b2, voffB); PG8_STAGE(PG8_SB(0, 1), b2 + hstep, voffB); PG8_STAGE(PG8_SA(0, 0), a2, voffA);
            PG8_WAIT_V(8); PG8_WAIT_L(0); PG8_BAR; PG8_MMA(1, 0, At, B0); PG8_MMA(1, 1, At, B1); PG8_BAR; PG8_SCHED;
            PG8_LDB(B0, 1, 0); PG8_LDB(B1, 1, 1); PG8_SCHED; PG8_LDA(At, 1, 0); PG8_STAGE(PG8_SA(0, 1), a2 + hstep, voffA);
            PG8_WAIT_V(8); PG8_WAIT_L(0); PG8_BAR; PG8_MMA(0, 0, At, B0); PG8_MMA(0, 1, At, B1); PG8_BAR; PG8_SCHED;
            PG8_LDA(At, 1, 1); PG8_STAGE(PG8_SB(1, 0), b3, voffB); PG8_STAGE(PG8_SB(1, 1), b3 + hstep, voffB); PG8_STAGE(PG8_SA(1, 0), a3, voffA);
            PG8_WAIT_V(8); PG8_WAIT_L(0); PG8_BAR; PG8_MMA(1, 0, At, B0); PG8_MMA(1, 1, At, B1); PG8_BAR; PG8_SCHED;
            } else {
            PG8_LDB(B0, 0, 0); PG8_SCHED; PG8_LDA(At, 0, 0); PG8_STAGE(PG8_SA(1, 1), a1 + hstep, voffA);
            PG8_WAIT_L(8); PG8_BAR; PG8_WAIT_L(0); PG8_MMA(0, 0, At, B0); PG8_BAR; PG8_SCHED;
            PG8_LDB(B1, 0, 1); PG8_STAGE(PG8_SB(0, 0), b2, voffB);
            PG8_BAR; PG8_WAIT_L(0); PG8_MMA(0, 1, At, B1); PG8_BAR;
            PG8_LDA(At, 0, 1); PG8_STAGE(PG8_SA(0, 0), a2, voffA);
            PG8_BAR; PG8_WAIT_L(0); PG8_MMA(1, 0, At, B0); PG8_BAR; PG8_SCHED;
            PG8_STAGE(PG8_SB(0, 1), b2 + hstep, voffB);
            PG8_WAIT_V(6); PG8_BAR; PG8_MMA(1, 1, At, B1); PG8_BAR;
            PG8_LDB(B0, 1, 0); PG8_SCHED; PG8_LDA(At, 1, 0); PG8_STAGE(PG8_SA(0, 1), a2 + hstep, voffA);
            PG8_WAIT_L(8); PG8_BAR; PG8_WAIT_L(0); PG8_MMA(0, 0, At, B0); PG8_BAR; PG8_SCHED;
            PG8_LDB(B1, 1, 1); PG8_STAGE(PG8_SB(1, 0), b3, voffB);
            PG8_BAR; PG8_WAIT_L(0); PG8_MMA(0, 1, At, B1); PG8_BAR;
            PG8_LDA(At, 1, 1); PG8_STAGE(PG8_SA(1, 0), a3, voffA);
            PG8_BAR; PG8_WAIT_L(0); PG8_MMA(1, 0, At, B0); PG8_BAR; PG8_SCHED;
            PG8_STAGE(PG8_SB(1, 1), b3 + hstep, voffB);
            PG8_WAIT_V(6); PG8_BAR; PG8_MMA(1, 1, At, B1); PG8_BAR;
            }
        }
        if constexpr (ALIGN_EPI) { if (wr == 0) PG8_BAR; }
        if constexpr (!Epi::AFTER_DRAIN) { E(acc, cur, wr, wc, fr, fq); S.done(cur); }
        if (!has_next) break;
#pragma unroll
        for (int a = 0; a < 2; ++a)
#pragma unroll
            for (int b = 0; b < 2; ++b)
#pragma unroll
                for (int m = 0; m < 4; ++m)
#pragma unroll
                    for (int n = 0; n < 2; ++n) acc[a][b][m][n] = (f32x4){0.f, 0.f, 0.f, 0.f};
        cur = nxt; cA = nA; cB = nB; ++ui;
        if constexpr (ALIGN_EPI) { if (wr == 1) PG8_BAR; }
    }
    PG8_WAIT_V(0);
    if constexpr (!ALIGN_EPI) { if (wr == 0) PG8_BAR; }
    PG8_BAR;
    if constexpr (Epi::AFTER_DRAIN) { E.fused(acc, cur, wr, wc, fr, fq, lds, wid, lane); S.done(cur); }
#undef PG8_SA
#undef PG8_SB
#undef PG8_STAGE
#undef PG8_LDA
#undef PG8_LDB
#undef PG8_MMA
#undef PG8_WAIT_V
#undef PG8_WAIT_L
#undef PG8_BAR
#undef PG8_SCHED
}
}

#ifndef PG8_SP2
#define PG8_SP2 true
#endif
#ifndef PG8_ALIGN
#define PG8_ALIGN true
#endif

constexpr int NWAVES = 8;
#ifndef MK_ONE_LAUNCH
#define MK_ONE_LAUNCH 1
#endif
constexpr int N_PHASES = 14;

constexpr int BATCH = 8, SEQ = 4096, D = 1024, FF = 2816, M = BATCH * SEQ;
constexpr int LRU_W = 512, NHEAD = 8, QK_NOPE = 64, QK_ROPE = 32, VDIM = 64, QLORA = 384, KVLORA = 256;
constexpr int IN_COLS = 2 * LRU_W + QLORA + KVLORA + QK_ROPE;
constexpr int IN_PAD = 1792;
constexpr int QW = NHEAD * (QK_NOPE + QK_ROPE);
constexpr int KVW = NHEAD * (QK_NOPE + VDIM);
constexpr int C_QLAT = 2 * LRU_W, C_KVLAT = C_QLAT + QLORA, C_KROPE = C_KVLAT + KVLORA;
constexpr float EPS = 1e-6f;
constexpr float QSCALE = 0.14724445f;
constexpr int NCHUNK = SEQ / 64;

constexpr size_t MiB = 1u << 20;
constexpr size_t WS_CTL = 0, CTL_ZERO_BYTES = 1 * MiB;
constexpr size_t WS_W1GU = 2 * MiB, WS_W1D = 13 * MiB, WS_W2GU = 19 * MiB, WS_W2D = 30 * MiB, WS_WIN = 36 * MiB, WS_WQB = 40 * MiB, WS_WKVB = 41 * MiB, WS_WLRU = 42 * MiB, WS_WOUT = 43 * MiB;
constexpr size_t WS_XN = 48 * MiB;
constexpr size_t WS_QLN = 48 * MiB, WS_KVLN = 72 * MiB;
constexpr size_t WS_Y = 48 * MiB;
constexpr size_t WS_HB = 112 * MiB;
constexpr size_t WS_PROJ = 112 * MiB, WS_GATES = 224 * MiB;
constexpr size_t WS_F = 288 * MiB;
constexpr size_t WS_Q = 288 * MiB, WS_KV = 336 * MiB;
constexpr size_t WS_KPE = 416 * MiB, WS_COS = 418 * MiB, WS_SIN = 420 * MiB, WS_AGG = 422 * MiB;
constexpr size_t WS_XC = 424 * MiB;
constexpr size_t WS_END = 456 * MiB;
constexpr int CW_TMO = 0, CW_CODE = 1;
constexpr int CW_BAR = 4096;

constexpr int RING_OFF = 0, RING_BYTES = 131072;
constexpr int LDSCTL_OFF = RING_BYTES, MISC_OFF = LDSCTL_OFF + 320;
constexpr int LDS_BYTES = 147456;

#define GAS __attribute__((address_space(1)))
#define LAS __attribute__((address_space(3)))
typedef unsigned short bf16;
typedef unsigned v4u __attribute__((ext_vector_type(4)));
typedef float f32x4 __attribute__((ext_vector_type(4)));
typedef short bf16x8 __attribute__((ext_vector_type(8)));
typedef GAS unsigned gu32;
typedef GAS unsigned long long gu64;
#define RLX_AGENT __ATOMIC_RELAXED, __HIP_MEMORY_SCOPE_AGENT
#define LDS_WAIT() asm volatile("s_waitcnt lgkmcnt(0)" ::: "memory")
#define VM_WAIT() asm volatile("s_waitcnt vmcnt(0)" ::: "memory")
__device__ __forceinline__ unsigned long long rt() { return __builtin_amdgcn_s_memrealtime(); }
__device__ __forceinline__ unsigned f2bf(float f) { unsigned u = __builtin_bit_cast(unsigned, f); return (u + 0x7fffu + ((u >> 16) & 1u)) >> 16; }
__device__ __forceinline__ unsigned pk2(float lo, float hi) { return f2bf(lo) | (f2bf(hi) << 16); }

#define XB_TMO      128
#define XB_XCNT(j)  (256  + 64 * (j))
#define XB_XSUB(j)  (1280 + 64 * (j))
#define XB_XGEN(j)  (2304 + 64 * (j))
#define XB_TOP      3328
#define XB_TOPGEN   3392
#define XCD_BAR_WORDS 3456
#define XB_SPIN_CAP (1u << 18)

__device__ __forceinline__ unsigned xb_ld(unsigned* p)              { return __hip_atomic_load(p, __ATOMIC_RELAXED, __HIP_MEMORY_SCOPE_AGENT); }
__device__ __forceinline__ unsigned xb_add(unsigned* p, unsigned v) { return __hip_atomic_fetch_add(p, v, __ATOMIC_RELAXED, __HIP_MEMORY_SCOPE_AGENT); }
__device__ __forceinline__ unsigned xb_xcc_id() { return (unsigned)__builtin_amdgcn_s_getreg((3 << 11) | 20) & 0xFu; }
#define XB_SPIN(cond, bar) do { unsigned _sp = 0; while (cond) { __builtin_amdgcn_s_sleep(1); \
    if ((++_sp & 255u) == 0u) { if (xb_ld(&(bar)[XB_TMO])) break; if (_sp > XB_SPIN_CAP) { atomicAdd(&(bar)[XB_TMO], 1u); break; } } } } while (0)

struct XcdBarrier {
    unsigned* bar; unsigned x;
    volatile LAS unsigned* st;
};

__device__ __forceinline__ XcdBarrier xcd_barrier_post(unsigned* bar, volatile LAS unsigned* st) {
    XcdBarrier b; b.bar = bar; b.x = xb_xcc_id(); b.st = st;
    if (threadIdx.x == 0) (void)xb_add(&bar[XB_XCNT(b.x)], 1u);
    return b;
}
__device__ __forceinline__ void xcd_barrier_complete(unsigned* bar, unsigned x, unsigned& nloc, unsigned& nx) {
    const unsigned G = gridDim.x * gridDim.y * gridDim.z;
    unsigned sum, cnt, mine, sp = 0u;
    for (;;) {
        sum = 0u; cnt = 0u; mine = 0u;
#pragma unroll
        for (unsigned j = 0; j < 16; ++j) { const unsigned c = xb_ld(&bar[XB_XCNT(j)]); sum += c; cnt += (c > 0u) ? 1u : 0u; mine = (j == x) ? c : mine; }
        if (sum == G) break;
        __builtin_amdgcn_s_sleep(1);
        if ((++sp & 255u) == 0u) { if (xb_ld(&bar[XB_TMO])) break; if (sp > XB_SPIN_CAP) { atomicAdd(&bar[XB_TMO], 1u); break; } }
    }
    nloc = mine > 0u ? mine : 1u; nx = cnt > 0u ? cnt : 1u;
}

__device__ __forceinline__ void xcd_barrier(const XcdBarrier& b) {
    asm volatile("s_waitcnt vmcnt(0)" ::: "memory");
    __syncthreads();
    if (threadIdx.x == 0) {
        unsigned* bar = b.bar;
        __builtin_amdgcn_s_waitcnt(0);
        unsigned nloc = b.st[0], nx = b.st[1];
        if (nloc == 0u) { xcd_barrier_complete(bar, b.x, nloc, nx); b.st[0] = nloc; b.st[1] = nx; }
        const unsigned old = xb_add(&bar[XB_XSUB(b.x)], 1u);
        const unsigned gen = old / nloc;
        if (old + 1u == (gen + 1u) * nloc) {
            __builtin_amdgcn_fence(__ATOMIC_RELEASE, "agent");
            asm volatile("s_waitcnt vmcnt(0)" ::: "memory");
            const unsigned og = xb_add(&bar[XB_TOP], 1u);
            const unsigned tg = og / nx;
            if (og + 1u == (tg + 1u) * nx) xb_add(&bar[XB_TOPGEN], 1u);
            else XB_SPIN(xb_ld(&bar[XB_TOPGEN]) == tg, bar);
            __builtin_amdgcn_fence(__ATOMIC_ACQUIRE, "agent");
            xb_add(&bar[XB_XGEN(b.x)], 1u);
            asm volatile("s_waitcnt vmcnt(0)" ::: "memory");
        } else {
            XB_SPIN(xb_ld(&bar[XB_XGEN(b.x)]) == gen, bar);
            __builtin_amdgcn_fence(__ATOMIC_ACQUIRE, "agent");
            asm volatile("s_waitcnt vmcnt(0)" ::: "memory");
        }
    }
    __syncthreads();
}

struct Frame {
    LAS unsigned char* lds;
    volatile LAS unsigned* MISC;
    gu32* ctl;
    int tid, lane, wave;
    int vcu, G;
};
__device__ __forceinline__ float bf2f(unsigned short u) { return __builtin_bit_cast(float, (unsigned)u << 16); }
__device__ __forceinline__ float bflo(unsigned w) { return __builtin_bit_cast(float, w << 16); }
__device__ __forceinline__ float bfhi(unsigned w) { return __builtin_bit_cast(float, w & 0xffff0000u); }
__device__ __forceinline__ float wave_sum(float v) {
#pragma unroll
    for (int o = 1; o < 64; o <<= 1) v += __shfl_xor(v, o);
    return v;
}
__device__ __forceinline__ float fexp(float x) { return __builtin_amdgcn_exp2f(x * 1.4426950408889634f); }
__device__ __forceinline__ float sigmoidf_(float z) { return __builtin_amdgcn_rcpf(1.0f + fexp(-z)); }
__device__ __forceinline__ float gelu_tanh(float x) {
    const float z = 0.7978845608028654f * (x + 0.044715f * x * x * x);
    const float t = 1.0f - 2.0f * __builtin_amdgcn_rcpf(fexp(2.0f * z) + 1.0f);
    return 0.5f * x * (1.0f + t);
}
__device__ __constant__ float INV_FREQ[16] = {1.000000000e+00f, 5.623413324e-01f, 3.162277639e-01f, 1.778279394e-01f, 1.000000015e-01f, 5.623412877e-02f, 3.162277862e-02f, 1.778279431e-02f,
                                              9.999999776e-03f, 5.623413250e-03f, 3.162277862e-03f, 1.778279431e-03f, 1.000000047e-03f, 5.623413017e-04f, 3.162277862e-04f, 1.778279402e-04f};

__device__ __forceinline__ void p0_transpose_item(const float* W, int K, int N, bf16* WT, int dst_row0, LAS float* scr, int k0, int n0, int lane) {
#pragma unroll 8
    for (int i = 0; i < 32; ++i) { const int kk = 2 * i + (lane >> 5); scr[kk * 33 + (lane & 31)] = W[(size_t)(k0 + kk) * N + n0 + (lane & 31)]; }
    LDS_WAIT(); asm volatile("" ::: "memory");
    const int c = lane & 7;
#pragma unroll
    for (int j = 0; j < 4; ++j) { const int n = (lane >> 3) + 8 * j; const LAS float* s = scr + (8 * c) * 33 + n;
        v4u o; o.x = pk2(s[0 * 33], s[1 * 33]); o.y = pk2(s[2 * 33], s[3 * 33]); o.z = pk2(s[4 * 33], s[5 * 33]); o.w = pk2(s[6 * 33], s[7 * 33]);
        *(GAS v4u*)(WT + (size_t)(dst_row0 + n) * K + k0 + 8 * c) = o; }
    LDS_WAIT(); asm volatile("" ::: "memory");
}
__device__ __forceinline__ void rms_row_to_bf16(int lane, const float* xrow, const float* g, bf16* orow) {
    const GAS f32x4* xr = (const GAS f32x4*)xrow + lane; const GAS f32x4* gr = (const GAS f32x4*)g + lane;
    f32x4 v[4]; float s = 0.f;
#pragma unroll
    for (int j = 0; j < 4; ++j) { v[j] = xr[64 * j]; s += (v[j].x * v[j].x + v[j].y * v[j].y) + (v[j].z * v[j].z + v[j].w * v[j].w); }
    const float rinv = 1.0f / sqrtf(wave_sum(s) * (1.f / D) + EPS);
    GAS unsigned long long* o8 = (GAS unsigned long long*)orow + lane;
#pragma unroll
    for (int j = 0; j < 4; ++j) { const f32x4 gg = gr[64 * j]; o8[64 * j] = (unsigned long long)pk2(v[j].x * rinv * gg.x, v[j].y * rinv * gg.y) | ((unsigned long long)pk2(v[j].z * rinv * gg.z, v[j].w * rinv * gg.w) << 32); }
}
struct P0Args { const float *x, *g1, *w1g, *w1u, *w1d, *w2g, *w2u, *w2d, *win, *wqb, *wkvb, *wout, *wla, *wlx; unsigned char* ws; };
__device__ __forceinline__ void p0_prologue(Frame& F, const P0Args& a) {
    LAS float* scr = (LAS float*)(F.lds + RING_OFF + F.wave * 16384);
    const int gw = F.vcu * NWAVES + F.wave, NGW = F.G * NWAVES;
    bf16* W1GU = (bf16*)(a.ws + WS_W1GU); bf16* W1D = (bf16*)(a.ws + WS_W1D); bf16* W2GU = (bf16*)(a.ws + WS_W2GU); bf16* W2D = (bf16*)(a.ws + WS_W2D);
    bf16* WIN = (bf16*)(a.ws + WS_WIN); bf16* WQB = (bf16*)(a.ws + WS_WQB); bf16* WKVB = (bf16*)(a.ws + WS_WKVB); bf16* WLRU = (bf16*)(a.ws + WS_WLRU); bf16* WOUT = (bf16*)(a.ws + WS_WOUT);
    constexpr int I_GU = (D / 64) * (FF / 32), I_DN = (FF / 64) * (D / 32), I_IN = (D / 64) * (IN_COLS / 32), I_QB = (QLORA / 64) * (QW / 32), I_KVB = (KVLORA / 64) * (KVW / 32), I_OUT = (D / 64) * (D / 32);
    constexpr int NITEMS = 4 * I_GU + 2 * I_DN + I_IN + I_QB + I_KVB + I_OUT;
    for (int it = gw; it < NITEMS; it += NGW) {
        int r = it;
        if (r < 4 * I_GU) {
            const int which = r / I_GU; r -= which * I_GU; const int nblk = FF / 32, kb = r / nblk, nb = r % nblk, n0 = 32 * nb;
            const float* W = which == 0 ? a.w1g : which == 1 ? a.w1u : which == 2 ? a.w2g : a.w2u; bf16* WT = which < 2 ? W1GU : W2GU;
            p0_transpose_item(W, D, FF, WT, 256 * (n0 / 128) + 128 * (which & 1) + (n0 % 128), scr, 64 * kb, n0, F.lane); continue; }
        r -= 4 * I_GU;
        if (r < 2 * I_DN) { const int which = r / I_DN; r -= which * I_DN; const int nblk = D / 32, kb = r / nblk, nb = r % nblk;
            p0_transpose_item(which ? a.w2d : a.w1d, FF, D, which ? W2D : W1D, 32 * nb, scr, 64 * kb, 32 * nb, F.lane); continue; }
        r -= 2 * I_DN;
        if (r < I_IN) { const int nblk = IN_COLS / 32, kb = r / nblk, nb = r % nblk; p0_transpose_item(a.win, D, IN_COLS, WIN, 32 * nb, scr, 64 * kb, 32 * nb, F.lane); continue; }
        r -= I_IN;
        if (r < I_QB) { const int nblk = QW / 32, kb = r / nblk, nb = r % nblk; p0_transpose_item(a.wqb, QLORA, QW, WQB, 32 * nb, scr, 64 * kb, 32 * nb, F.lane); continue; }
        r -= I_QB;
        if (r < I_KVB) { const int nblk = KVW / 32, kb = r / nblk, nb = r % nblk; p0_transpose_item(a.wkvb, KVLORA, KVW, WKVB, 32 * nb, scr, 64 * kb, 32 * nb, F.lane); continue; }
        r -= I_KVB;
        { const int nblk = D / 32, kb = r / nblk, nb = r % nblk; p0_transpose_item(a.wout, D, D, WOUT, 32 * nb, scr, 64 * kb, 32 * nb, F.lane); }
    }
    { const int gt = (F.vcu * NWAVES + F.wave) * 64 + F.lane, NGT = NGW * 64; GAS unsigned* p = (GAS unsigned*)(WIN + (size_t)IN_COLS * D);
      for (int i = gt; i < (IN_PAD - IN_COLS) * D / 2; i += NGT) p[i] = 0u; }
    { const int gt = (F.vcu * NWAVES + F.wave) * 64 + F.lane, NGT = NGW * 64; GAS unsigned* p = (GAS unsigned*)WLRU;
      for (int i = gt; i < 1024 * 512 / 2; i += NGT) { const int np = i / 256, k = (i % 256) * 2; const int half = np >> 9, c = np & 511, blk = c >> 6, e = c & 63, kb = k >> 6, d = k & 63;
          const float* w = half ? a.wlx : a.wla; unsigned o = 0u; if (kb == blk) o = pk2(w[blk * 4096 + d * 64 + e], w[blk * 4096 + (d + 1) * 64 + e]); p[i] = o; } }
    bf16* XN = (bf16*)(a.ws + WS_XN);
    for (int m = gw; m < M; m += NGW) rms_row_to_bf16(F.lane, a.x + (size_t)m * D, a.g1, XN + (size_t)m * D);
}

__device__ __forceinline__ void rowpass(Frame& F, const float* Fm, const float* base, float* out, const float* g_post, float coef, const float* g_next, bf16* XN) {
    const int gw = F.vcu * NWAVES + F.wave, NGW = F.G * NWAVES, lane = F.lane;
    for (int m = gw; m < M; m += NGW) {
        const GAS f32x4* fr = (const GAS f32x4*)(Fm + (size_t)m * D) + lane; const GAS f32x4* br = (const GAS f32x4*)(base + (size_t)m * D) + lane;
        const GAS f32x4* gp = (const GAS f32x4*)g_post + lane;
        f32x4 v[4], b[4]; float s = 0.f;
#pragma unroll
        for (int j = 0; j < 4; ++j) { v[j] = fr[64 * j]; b[j] = br[64 * j]; s += (v[j].x * v[j].x + v[j].y * v[j].y) + (v[j].z * v[j].z + v[j].w * v[j].w); }
        const float rinv = coef / sqrtf(wave_sum(s) * (1.f / D) + EPS);
        float s2 = 0.f;
#pragma unroll
        for (int j = 0; j < 4; ++j) { const f32x4 gg = gp[64 * j]; v[j] = b[j] + v[j] * rinv * gg; s2 += (v[j].x * v[j].x + v[j].y * v[j].y) + (v[j].z * v[j].z + v[j].w * v[j].w); }
        GAS f32x4* orow = (GAS f32x4*)(out + (size_t)m * D) + lane;
#pragma unroll
        for (int j = 0; j < 4; ++j) orow[64 * j] = v[j];
        if (XN) {
            const float r2 = 1.0f / sqrtf(wave_sum(s2) * (1.f / D) + EPS); const GAS f32x4* gn = (const GAS f32x4*)g_next + lane;
            GAS unsigned long long* o8 = (GAS unsigned long long*)(XN + (size_t)m * D) + lane;
#pragma unroll
            for (int j = 0; j < 4; ++j) { const f32x4 gg = gn[64 * j]; o8[64 * j] = (unsigned long long)pk2(v[j].x * r2 * gg.x, v[j].y * r2 * gg.y) | ((unsigned long long)pk2(v[j].z * r2 * gg.z, v[j].w * r2 * gg.w) << 32); }
        }
    }
}

struct PrepArgs { const int* pos; const float *gq, *gkv, *cw, *cb; unsigned char* ws; };
__device__ __forceinline__ void prep_pass(Frame& F, const PrepArgs& a) {
    const int gw = F.vcu * NWAVES + F.wave, NGW = F.G * NWAVES, lane = F.lane;
    const bf16* PROJ = (const bf16*)(a.ws + WS_PROJ); bf16* QLN = (bf16*)(a.ws + WS_QLN); bf16* KVLN = (bf16*)(a.ws + WS_KVLN); bf16* KPE = (bf16*)(a.ws + WS_KPE);
    float* COS = (float*)(a.ws + WS_COS); float* SIN = (float*)(a.ws + WS_SIN); bf16* XC = (bf16*)(a.ws + WS_XC);
    for (int m = gw; m < M; m += NGW) {
        const bf16* pr = PROJ + (size_t)m * IN_PAD;
        {
            const GAS unsigned* p = (const GAS unsigned*)(pr + C_QLAT + lane * 6); const unsigned w0 = p[0], w1 = p[1], w2 = p[2];
            float v[6] = {bflo(w0), bfhi(w0), bflo(w1), bfhi(w1), bflo(w2), bfhi(w2)}; float s = 0.f;
#pragma unroll
            for (int j = 0; j < 6; ++j) s += v[j] * v[j];
            const float rinv = 1.0f / sqrtf(wave_sum(s) * (1.f / QLORA) + EPS); const float* g = a.gq + lane * 6;
            GAS unsigned* o = (GAS unsigned*)(QLN + (size_t)m * QLORA + lane * 6);
            o[0] = pk2(v[0] * rinv * g[0], v[1] * rinv * g[1]); o[1] = pk2(v[2] * rinv * g[2], v[3] * rinv * g[3]); o[2] = pk2(v[4] * rinv * g[4], v[5] * rinv * g[5]);
        }
        {
            const GAS unsigned* p = (const GAS unsigned*)(pr + C_KVLAT + lane * 4); const unsigned w0 = p[0], w1 = p[1];
            float v[4] = {bflo(w0), bfhi(w0), bflo(w1), bfhi(w1)}; float s = (v[0] * v[0] + v[1] * v[1]) + (v[2] * v[2] + v[3] * v[3]);
            const float rinv = 1.0f / sqrtf(wave_sum(s) * (1.f / KVLORA) + EPS); const float* g = a.gkv + lane * 4;
            GAS unsigned* o = (GAS unsigned*)(KVLN + (size_t)m * KVLORA + lane * 4);
            o[0] = pk2(v[0] * rinv * g[0], v[1] * rinv * g[1]); o[1] = pk2(v[2] * rinv * g[2], v[3] * rinv * g[3]);
        }
        if (lane < 16) {
            const float x1 = bf2f(pr[C_KROPE + lane]), x2 = bf2f(pr[C_KROPE + 16 + lane]);
            const float ang = (float)a.pos[m] * INV_FREQ[lane];
            double rev = (double)ang * 0.15915494309189535; rev -= __builtin_rint(rev); const float fr = (float)rev;
            const float sn = __builtin_amdgcn_sinf(fr), cs = __builtin_amdgcn_cosf(fr);
            KPE[(size_t)m * 32 + lane] = (bf16)f2bf(x1 * cs - x2 * sn); KPE[(size_t)m * 32 + 16 + lane] = (bf16)f2bf(x2 * cs + x1 * sn);
            COS[(size_t)m * 16 + lane] = cs; SIN[(size_t)m * 16 + lane] = sn;
        }
        {
            const int t = m % SEQ; float acc[8];
#pragma unroll
            for (int j = 0; j < 8; ++j) acc[j] = a.cb[lane * 8 + j];
#pragma unroll
            for (int k = 0; k < 4; ++k) { const int tt = t - 3 + k; if (tt >= 0) {
                const v4u w = *(const GAS v4u*)(PROJ + (size_t)(m - 3 + k) * IN_PAD + lane * 8); const float* cwk = a.cw + k * LRU_W + lane * 8;
                acc[0] += cwk[0] * bflo(w.x); acc[1] += cwk[1] * bfhi(w.x); acc[2] += cwk[2] * bflo(w.y); acc[3] += cwk[3] * bfhi(w.y);
                acc[4] += cwk[4] * bflo(w.z); acc[5] += cwk[5] * bfhi(w.z); acc[6] += cwk[6] * bflo(w.w); acc[7] += cwk[7] * bfhi(w.w); } }
            v4u o; o.x = pk2(acc[0], acc[1]); o.y = pk2(acc[2], acc[3]); o.z = pk2(acc[4], acc[5]); o.w = pk2(acc[6], acc[7]);
            *(GAS v4u*)(XC + (size_t)m * LRU_W + lane * 8) = o;
        }
    }
}

__device__ __forceinline__ void qrope_pass(Frame& F, unsigned char* ws) {
    const int gw = F.vcu * NWAVES + F.wave, NGW = F.G * NWAVES, lane = F.lane;
    bf16* Q = (bf16*)(ws + WS_Q); const float* COS = (const float*)(ws + WS_COS); const float* SIN = (const float*)(ws + WS_SIN);
    for (int m = gw; m < M; m += NGW) {
        bf16* q = Q + (size_t)m * QW;
#pragma unroll
        for (int pp = 0; pp < 2; ++pp) { const int p = lane + 64 * pp, h = p >> 4, i = p & 15; bf16* qa = q + h * 96 + 64 + i;
            const float x1 = bf2f(qa[0]), x2 = bf2f(qa[16]); const float cs = COS[(size_t)m * 16 + i], sn = SIN[(size_t)m * 16 + i];
            qa[0] = (bf16)f2bf((x1 * cs - x2 * sn) * QSCALE); qa[16] = (bf16)f2bf((x2 * cs + x1 * sn) * QSCALE); }
        {
            GAS v4u* p = (GAS v4u*)(q + (lane >> 3) * 96 + (lane & 7) * 8); const v4u w = *p; v4u o;
            o.x = pk2(bflo(w.x) * QSCALE, bfhi(w.x) * QSCALE); o.y = pk2(bflo(w.y) * QSCALE, bfhi(w.y) * QSCALE); o.z = pk2(bflo(w.z) * QSCALE, bfhi(w.z) * QSCALE); o.w = pk2(bflo(w.w) * QSCALE, bfhi(w.w) * QSCALE);
            *p = o; }
    }
}

struct LruCh { float ba, bx, sp8; };
__device__ __forceinline__ LruCh lru_channel(const float* ba, const float* bx, const float* lam, int c) {
    LruCh r; r.ba = ba[c]; r.bx = bx[c]; const float y = fexp(-lam[c]);
    const float sp = (y > 0.05f) ? __logf(1.0f + y) : y * (1.0f + y * (-0.5f + y * (0.33333333f + y * (-0.25f + y * 0.2f))));
    r.sp8 = 8.0f * sp; return r;
}
__device__ __forceinline__ void lru_au(const LruCh& ch, float rpre, float ipre, float xc, float& a, float& u) {
    const float r = sigmoidf_(rpre + ch.ba), ig = sigmoidf_(ipre + ch.bx);
    const float la = -ch.sp8 * r; a = fexp(la);
    const float x = 2.0f * la;
    const float em = (x > -0.25f) ? -x * (1.0f + x * (0.5f + x * (0.16666667f + x * (0.041666667f + x * (0.0083333333f + x * 0.0013888889f))))) : 1.0f - fexp(x);
    u = sqrtf(em) * (ig * xc);
}
struct ScanArgs { const float *ba, *bx, *lam; unsigned char* ws; };
__device__ __forceinline__ void scan_pass1(Frame& F, const ScanArgs& a) {
    const bf16* GATES = (const bf16*)(a.ws + WS_GATES); const bf16* XC = (const bf16*)(a.ws + WS_XC); float* AGG = (float*)(a.ws + WS_AGG);
    const int c = F.tid; const LruCh ch = lru_channel(a.ba, a.bx, a.lam, c);
    for (int cu = F.vcu; cu < BATCH * NCHUNK; cu += F.G) {
        const size_t row0 = (size_t)cu * 64; float A = 1.0f, H = 0.0f;
#pragma unroll 8
        for (int t = 0; t < 64; ++t) { const size_t r = row0 + t; float av, uv;
            lru_au(ch, bf2f(GATES[r * 1024 + c]), bf2f(GATES[r * 1024 + 512 + c]), bf2f(XC[r * LRU_W + c]), av, uv);
            A *= av; H = av * H + uv; }
        AGG[((size_t)cu * LRU_W + c) * 2] = A; AGG[((size_t)cu * LRU_W + c) * 2 + 1] = H;
    }
}
__device__ __forceinline__ void scan_pass2(Frame& F, const ScanArgs& a) {
    const bf16* GATES = (const bf16*)(a.ws + WS_GATES); const bf16* XC = (const bf16*)(a.ws + WS_XC); const float* AGG = (const float*)(a.ws + WS_AGG);
    const bf16* PROJ = (const bf16*)(a.ws + WS_PROJ); bf16* Y = (bf16*)(a.ws + WS_Y);
    const int c = F.tid; const LruCh ch = lru_channel(a.ba, a.bx, a.lam, c);
    for (int cu = F.vcu; cu < BATCH * NCHUNK; cu += F.G) {
        const int b = cu / NCHUNK, ci = cu % NCHUNK; float h = 0.0f;
        for (int j = 0; j < ci; ++j) { const size_t o = ((size_t)(b * NCHUNK + j) * LRU_W + c) * 2; h = AGG[o] * h + AGG[o + 1]; }
        const size_t row0 = (size_t)cu * 64;
#pragma unroll 8
        for (int t = 0; t < 64; ++t) { const size_t r = row0 + t; float av, uv;
            lru_au(ch, bf2f(GATES[r * 1024 + c]), bf2f(GATES[r * 1024 + 512 + c]), bf2f(XC[r * LRU_W + c]), av, uv);
            h = av * h + uv; const float g = bf2f(PROJ[r * IN_PAD + LRU_W + c]);
            Y[r * D + c] = (bf16)f2bf(h * gelu_tanh(g)); }
    }
}

__device__ __forceinline__ void attn_naive(Frame& F, unsigned char* ws) {
    const bf16* Q = (const bf16*)(ws + WS_Q); const bf16* KV = (const bf16*)(ws + WS_KV); const bf16* KPE = (const bf16*)(ws + WS_KPE); bf16* Y = (bf16*)(ws + WS_Y);
    for (int u = F.vcu; u < 512; u += F.G) {
        const int uu = u & 255, bh = uu >> 2, qb = (u < 256) ? (uu & 3) : 7 - (uu & 3); const int b = bh >> 3, h = bh & 7;
        const int t = qb * 512 + F.tid; const size_t row = (size_t)b * SEQ + t;
        float q[96], o[64];
        { const GAS v4u* qp = (const GAS v4u*)(Q + row * QW + h * 96);
#pragma unroll
          for (int j = 0; j < 12; ++j) { const v4u w = qp[j]; q[8 * j] = bflo(w.x); q[8 * j + 1] = bfhi(w.x); q[8 * j + 2] = bflo(w.y); q[8 * j + 3] = bfhi(w.y); q[8 * j + 4] = bflo(w.z); q[8 * j + 5] = bfhi(w.z); q[8 * j + 6] = bflo(w.w); q[8 * j + 7] = bfhi(w.w); } }
#pragma unroll
        for (int d = 0; d < 64; ++d) o[d] = 0.f;
        float mx = -1e30f, l = 0.f;
        const int nk = __builtin_amdgcn_readfirstlane(((t >> 6) + 1) << 6);
        for (int j = 0; j < nk; ++j) {
            const size_t kr = (size_t)b * SEQ + j; const GAS v4u* kn = (const GAS v4u*)(KV + kr * KVW + h * 128); const GAS v4u* kp = (const GAS v4u*)(KPE + kr * 32);
            float s = 0.f;
#pragma unroll
            for (int jj = 0; jj < 8; ++jj) { const v4u w = kn[jj]; s += q[8 * jj] * bflo(w.x) + q[8 * jj + 1] * bfhi(w.x) + q[8 * jj + 2] * bflo(w.y) + q[8 * jj + 3] * bfhi(w.y) + q[8 * jj + 4] * bflo(w.z) + q[8 * jj + 5] * bfhi(w.z) + q[8 * jj + 6] * bflo(w.w) + q[8 * jj + 7] * bfhi(w.w); }
#pragma unroll
            for (int jj = 0; jj < 4; ++jj) { const v4u w = kp[jj]; s += q[64 + 8 * jj] * bflo(w.x) + q[64 + 8 * jj + 1] * bfhi(w.x) + q[64 + 8 * jj + 2] * bflo(w.y) + q[64 + 8 * jj + 3] * bfhi(w.y) + q[64 + 8 * jj + 4] * bflo(w.z) + q[64 + 8 * jj + 5] * bfhi(w.z) + q[64 + 8 * jj + 6] * bflo(w.w) + q[64 + 8 * jj + 7] * bfhi(w.w); }
            const float mn = fmaxf(mx, s), al = __builtin_amdgcn_exp2f(mx - mn), p = __builtin_amdgcn_exp2f(s - mn); mx = mn; l = l * al + p;
#pragma unroll
            for (int jj = 0; jj < 8; ++jj) { const v4u w = kn[8 + jj];
                o[8 * jj] = o[8 * jj] * al + p * bflo(w.x); o[8 * jj + 1] = o[8 * jj + 1] * al + p * bfhi(w.x); o[8 * jj + 2] = o[8 * jj + 2] * al + p * bflo(w.y); o[8 * jj + 3] = o[8 * jj + 3] * al + p * bfhi(w.y);
                o[8 * jj + 4] = o[8 * jj + 4] * al + p * bflo(w.z); o[8 * jj + 5] = o[8 * jj + 5] * al + p * bfhi(w.z); o[8 * jj + 6] = o[8 * jj + 6] * al + p * bflo(w.w); o[8 * jj + 7] = o[8 * jj + 7] * al + p * bfhi(w.w); }
        }
        const float rl = 1.0f / l; GAS v4u* yp = (GAS v4u*)(Y + row * D + 512 + h * 64);
#pragma unroll
        for (int jj = 0; jj < 8; ++jj) { v4u w; w.x = pk2(o[8 * jj] * rl, o[8 * jj + 1] * rl); w.y = pk2(o[8 * jj + 2] * rl, o[8 * jj + 3] * rl); w.z = pk2(o[8 * jj + 4] * rl, o[8 * jj + 5] * rl); w.w = pk2(o[8 * jj + 6] * rl, o[8 * jj + 7] * rl); yp[jj] = w; }
    }
}


namespace att {
using bf16x8 = __attribute__((ext_vector_type(8))) short;
using s16x4 = __attribute__((ext_vector_type(4))) short;
using f32x16 = __attribute__((ext_vector_type(16))) float;
using u32x4 = __attribute__((ext_vector_type(4))) unsigned;
typedef unsigned short bf16;
constexpr int KSLOT = 12288, VSLOT = 8192, NSLOT = 3;
constexpr int L_K = 0, L_V = NSLOT * KSLOT, L_WS = L_V + NSLOT * VSLOT, L_OST = L_WS + 8 * 64 * 4, L_END = L_OST + 8 * 4096;
__device__ __forceinline__ int crow(int r, int hi) { return (r & 3) + 8 * (r >> 2) + 4 * hi; }
__device__ __forceinline__ void glds16(const void* gsrc, unsigned lds_dst) { unsigned keep;
    asm volatile("s_mov_b32 %0, m0\n\ts_mov_b32 m0, %2\n\ts_nop 0\n\tglobal_load_lds_dwordx4 %1, off\n\ts_mov_b32 m0, %0" : "=&s"(keep) : "v"(gsrc), "s"(lds_dst) : "memory"); }
typedef float f32x2_t __attribute__((ext_vector_type(2))); typedef __bf16 bf16x2_t __attribute__((ext_vector_type(2)));
__device__ __forceinline__ unsigned cvtpk(float lo, float hi) { f32x2_t v = {lo, hi}; bf16x2_t b = __builtin_convertvector(v, bf16x2_t); return __builtin_bit_cast(unsigned, b); }
#define ATT_SBAR() __builtin_amdgcn_sched_barrier(0)

__device__ __forceinline__ void qkt(f32x16& p0, f32x16& p1, const char* Kslot, const bf16x8* qr, int r32, int hi) {
    const char* kb = Kslot + hi * 1024 + r32 * 16;
    p0 = f32x16{}; p1 = f32x16{};
#pragma unroll
    for (int d0 = 0; d0 < 6; ++d0) {
        const bf16x8 b0 = *reinterpret_cast<const bf16x8*>(kb + d0 * 2048);
        const bf16x8 b1 = *reinterpret_cast<const bf16x8*>(kb + d0 * 2048 + 512);
        p0 = __builtin_amdgcn_mfma_f32_32x32x16_bf16(b0, qr[d0], p0, 0, 0, 0); p1 = __builtin_amdgcn_mfma_f32_32x32x16_bf16(b1, qr[d0], p1, 0, 0, 0); }
}
__device__ __forceinline__ float rowmax(const f32x16& p0, const f32x16& p1) {
    float a = fmaxf(p0[0], p1[0]);
#pragma unroll
    for (int r = 1; r < 16; ++r) a = fmaxf(a, fmaxf(p0[r], p1[r]));
    auto rr = __builtin_amdgcn_permlane32_swap(__float_as_uint(a), __float_as_uint(a), false, false);
    return fmaxf(__uint_as_float(rr[0]), __uint_as_float(rr[1]));
}
__device__ __forceinline__ void pv(f32x16* o, int vb, bf16x8 pa0, bf16x8 pa1, bf16x8 pa2, bf16x8 pa3) {
#pragma unroll
    for (int d0 = 0; d0 < 2; ++d0) { s16x4 lo[4], hi[4];
#pragma unroll
        for (int ks = 0; ks < 4; ++ks) {
            asm volatile("ds_read_b64_tr_b16 %0,%1 offset:%c2" : "=&v"(lo[ks]) : "v"(vb), "i"(d0 * 4096 + ks * 1024) : "memory");
            asm volatile("ds_read_b64_tr_b16 %0,%1 offset:%c2" : "=&v"(hi[ks]) : "v"(vb), "i"(d0 * 4096 + ks * 1024 + 512) : "memory"); }
        asm volatile("s_waitcnt lgkmcnt(0)" ::: "memory"); ATT_SBAR();
#define ATT_PK(k) (bf16x8){lo[k][0], lo[k][1], lo[k][2], lo[k][3], hi[k][0], hi[k][1], hi[k][2], hi[k][3]}
        o[d0] = __builtin_amdgcn_mfma_f32_32x32x16_bf16(pa0, ATT_PK(0), o[d0], 0, 0, 0);
        o[d0] = __builtin_amdgcn_mfma_f32_32x32x16_bf16(pa1, ATT_PK(1), o[d0], 0, 0, 0);
        o[d0] = __builtin_amdgcn_mfma_f32_32x32x16_bf16(pa2, ATT_PK(2), o[d0], 0, 0, 0);
        o[d0] = __builtin_amdgcn_mfma_f32_32x32x16_bf16(pa3, ATT_PK(3), o[d0], 0, 0, 0);
#undef ATT_PK
    }
}
constexpr int SEQ_ = 4096, QW_ = 768, KVW_ = 1024, YW_ = 1024;
__device__ __forceinline__ void attn_unit(int b, int h, int qb, const bf16* Q, const bf16* __restrict__ KV, const bf16* __restrict__ KPE, bf16* Y, char* shm) {
    const int tid = threadIdx.x, lane = tid & 63, r32 = lane & 31, hi = lane >> 5; const int wid = __builtin_amdgcn_readfirstlane(tid >> 6);
    const long rowbase = (long)b * SEQ_; const int q0 = qb * 256;
    const bf16* Qw = Q + (rowbase + q0 + wid * 32) * QW_ + h * 96;
    const unsigned lds0 = (unsigned)(uintptr_t)shm;
    float* wsf = (float*)(shm + L_WS) + wid * 64;
    const bf16* ksrc = KV + (rowbase + lane) * KVW_ + h * 128 + wid * 8;
    const bf16* psrc = KPE + (rowbase + lane) * 32 + (wid & 3) * 8;
    const bf16* vsrc = KV + (rowbase + 16 * (wid & 3) + (lane >> 2)) * KVW_ + h * 128 + 64 + (wid >> 2) * 32 + (lane & 3) * 8;
    const unsigned kdst = lds0 + L_K + wid * 1024, pdst = lds0 + L_K + (8 + (wid & 3)) * 1024, vdst = lds0 + L_V + wid * 1024;
#define ATT_DMA(t, sl) do { glds16(ksrc + (long)(t) * 64 * KVW_, (unsigned)__builtin_amdgcn_readfirstlane(kdst + (sl) * KSLOT)); \
        glds16(psrc + (long)(t) * 64 * 32, (unsigned)__builtin_amdgcn_readfirstlane(pdst + (sl) * KSLOT)); \
        glds16(vsrc + (long)(t) * 64 * KVW_, (unsigned)__builtin_amdgcn_readfirstlane(vdst + (sl) * VSLOT)); } while (0)
    const int vb0 = (int)(lds0 + L_V) + ((lane >> 4) & 1) * 32 + (lane & 3) * 8 + (4 * hi + ((lane & 15) >> 2)) * 64;
    const int NT = 4 * qb + 4, tmax = 4 * qb + (wid >> 1);
    ATT_DMA(0, 0); ATT_DMA(1, 1);
    bf16x8 qr[6];
#pragma unroll
    for (int d0 = 0; d0 < 6; ++d0) qr[d0] = *reinterpret_cast<const bf16x8*>(&Qw[(long)r32 * QW_ + d0 * 16 + hi * 8]);
    float mrow = -1e30f, l_reg = 0.f; f32x16 o[2]; o[0] = f32x16{}; o[1] = f32x16{};
    int sl = 0, sl2 = 2;
    for (int t = 0; t < NT; ++t) {
        if (t + 1 < NT) asm volatile("s_waitcnt vmcnt(3)" ::: "memory"); else asm volatile("s_waitcnt vmcnt(0)" ::: "memory");
        asm volatile("s_waitcnt lgkmcnt(0)\n\ts_barrier" ::: "memory");
        if (t + 2 < NT) ATT_DMA(t + 2, sl2);
        if (t <= tmax) {
            f32x16 p0, p1;
            qkt(p0, p1, shm + L_K + sl * KSLOT, qr, r32, hi);
            const float rm = rowmax(p0, p1);
            const float mn = fmaxf(mrow, rm), al = __builtin_amdgcn_exp2f(mrow - mn); mrow = mn;
            float sacc = 0.f;
#pragma unroll
            for (int r = 0; r < 16; ++r) { p0[r] = __builtin_amdgcn_exp2f(p0[r] - mn); p1[r] = __builtin_amdgcn_exp2f(p1[r] - mn); sacc += p0[r] + p1[r]; }
            l_reg = l_reg * al + sacc;
            if (hi == 0) wsf[r32] = al;
            asm volatile("s_waitcnt lgkmcnt(0)" ::: "memory");
#pragma unroll
            for (int r = 0; r < 16; ++r) { const float f = wsf[crow(r, hi)]; o[0][r] *= f; o[1][r] *= f; }
            u32x4 pw0, pw1, pw2, pw3;
            pw0 = (u32x4){cvtpk(p0[0], p0[1]), cvtpk(p0[2], p0[3]), cvtpk(p0[4], p0[5]), cvtpk(p0[6], p0[7])};
            pw1 = (u32x4){cvtpk(p0[8], p0[9]), cvtpk(p0[10], p0[11]), cvtpk(p0[12], p0[13]), cvtpk(p0[14], p0[15])};
            pw2 = (u32x4){cvtpk(p1[0], p1[1]), cvtpk(p1[2], p1[3]), cvtpk(p1[4], p1[5]), cvtpk(p1[6], p1[7])};
            pw3 = (u32x4){cvtpk(p1[8], p1[9]), cvtpk(p1[10], p1[11]), cvtpk(p1[12], p1[13]), cvtpk(p1[14], p1[15])};
            ATT_SBAR();
            pv(o, vb0 + sl * VSLOT, __builtin_bit_cast(bf16x8, pw0), __builtin_bit_cast(bf16x8, pw1), __builtin_bit_cast(bf16x8, pw2), __builtin_bit_cast(bf16x8, pw3));
        }
        sl = (sl == NSLOT - 1) ? 0 : sl + 1; sl2 = (sl2 == NSLOT - 1) ? 0 : sl2 + 1;
    }
    { auto rr = __builtin_amdgcn_permlane32_swap(__float_as_uint(l_reg), __float_as_uint(l_reg), false, false); l_reg = __uint_as_float(rr[0]) + __uint_as_float(rr[1]); }
    if (hi == 0) wsf[32 + r32] = l_reg; asm volatile("s_waitcnt lgkmcnt(0)" ::: "memory");
    float rli[16];
#pragma unroll
    for (int r = 0; r < 16; ++r) rli[r] = __builtin_amdgcn_rcpf(wsf[32 + crow(r, hi)]);
    bf16* Ow = Y + (rowbase + q0 + wid * 32) * YW_ + 512 + h * 64;
    { bf16* stg = (bf16*)(shm + L_OST) + wid * 2048;
#pragma unroll
      for (int r = 0; r < 16; ++r) { const int orow = crow(r, hi);
#pragma unroll
          for (int d0 = 0; d0 < 2; ++d0) { const float v = o[d0][r] * rli[r]; const unsigned u = __builtin_bit_cast(unsigned, v); stg[orow * 64 + d0 * 32 + r32] = (bf16)((u + 0x7fffu + ((u >> 16) & 1u)) >> 16); } }
      asm volatile("s_waitcnt lgkmcnt(0)" ::: "memory");
#pragma unroll
      for (int i = 0; i < 4; ++i) { const int row = i * 8 + (lane >> 3), ch = lane & 7; const u32x4 v = *(const u32x4*)(stg + row * 64 + ch * 8); *(u32x4*)(Ow + (long)row * YW_ + ch * 8) = v; } }
    asm volatile("s_waitcnt vmcnt(0) lgkmcnt(0)\n\ts_barrier" ::: "memory");
#undef ATT_DMA
}
__device__ __forceinline__ void attn_phase(char* lds, int vcu, int G, const bf16* Q, const bf16* KV, const bf16* KPE, bf16* Y) {
    for (int v = vcu; v < 256; v += G) {
        const int bh = v >> 2, s = v & 3;
        for (int i = 0; i < 4; ++i) { const int qb = (i == 0) ? s : (i == 1) ? 7 - s : (i == 2) ? 8 + s : 15 - s; attn_unit(bh >> 3, bh & 7, qb, Q, KV, KPE, Y, lds); }
    }
}
#undef ATT_SBAR
}

#ifndef USE_MFMA_ATTN
#define USE_MFMA_ATTN 1
#endif
struct Args { const float* in[27]; float* out; unsigned char* ws; int ph_lo, ph_hi, li, pad; };
__global__ void __launch_bounds__(NWAVES * 64, 2) mega_fwd(Args args) {
    extern __shared__ __attribute__((aligned(16))) unsigned char lds[];
    Frame F;
    F.lds = (LAS unsigned char*)lds;
    F.MISC = (volatile LAS unsigned*)(F.lds + MISC_OFF);
    F.tid = threadIdx.x; F.lane = F.tid & 63; F.wave = __builtin_amdgcn_readfirstlane(F.tid >> 6);
    F.G = gridDim.x; { const int bx = blockIdx.x; F.vcu = (F.G % 8 == 0) ? (bx % 8) * (F.G / 8) + bx / 8 : bx; }
    unsigned char* ws = args.ws;
    F.ctl = (gu32*)(ws + WS_CTL);
    for (int u = F.tid; u < (LDS_BYTES - LDSCTL_OFF) / 4; u += NWAVES * 64) ((LAS unsigned*)(F.lds + LDSCTL_OFF))[u] = 0u;
    __syncthreads();
    XcdBarrier bar; bar.bar = (unsigned*)(F.ctl + CW_BAR); bar.x = 0; bar.st = nullptr;
    const int lo = args.ph_lo, hi = args.ph_hi;
    if (hi - lo > 1) bar = xcd_barrier_post((unsigned*)(F.ctl + CW_BAR), F.MISC + 8);

    const float* x = args.in[0]; const int* pos = (const int*)args.in[1];
    bf16* XN = (bf16*)(ws + WS_XN); bf16* HB = (bf16*)(ws + WS_HB); float* Fm = (float*)(ws + WS_F); bf16* Y = (bf16*)(ws + WS_Y);
    bf16* PROJ = (bf16*)(ws + WS_PROJ); bf16* GATES = (bf16*)(ws + WS_GATES); bf16* Qb = (bf16*)(ws + WS_Q); bf16* KVb = (bf16*)(ws + WS_KV);

#define IN(k) (lo <= (k) && (k) < hi)
#define SEAM(k) do { if (IN(k) && IN((k) + 1)) { xcd_barrier(bar); } } while (0)
#define GEMM_SWIGLU(WOFF) do { pg8::Gemm g{XN, (const bf16*)(ws + (WOFF)), M, 2 * FF, D}; pg8::StaticOrder S; S.init(M, 2 * FF, F.G, (int)blockIdx.x); pg8::EpiSwiglu E{HB, FF}; \
        pg8::gemm_phase<pg8::EpiSwiglu, pg8::StaticOrder, PG8_ALIGN, PG8_SP2>(F.lds + RING_OFF, g, S, E); } while (0)
#define GEMM_F32(A_, WOFF, K_) do { pg8::Gemm g{(A_), (const bf16*)(ws + (WOFF)), M, D, (K_)}; pg8::StaticOrder S; S.init(M, D, F.G, (int)blockIdx.x); pg8::EpiF32 E{Fm, D}; \
        pg8::gemm_phase<pg8::EpiF32, pg8::StaticOrder, PG8_ALIGN, PG8_SP2>(F.lds + RING_OFF, g, S, E); } while (0)
#define GEMM_BF16(A_, WOFF, N_, K_, O_) do { pg8::Gemm g{(A_), (const bf16*)(ws + (WOFF)), M, (N_), (K_)}; pg8::StaticOrder S; S.init(M, (N_), F.G, (int)blockIdx.x); pg8::EpiBf16 E{(O_), (N_)}; \
        pg8::gemm_phase<pg8::EpiBf16, pg8::StaticOrder, PG8_ALIGN, PG8_SP2>(F.lds + RING_OFF, g, S, E); } while (0)
    if (IN(0)) { P0Args a{x, args.in[2], args.in[4], args.in[5], args.in[6], args.in[24], args.in[25], args.in[26], args.in[9], args.in[18], args.in[20], args.in[21], args.in[12], args.in[14], ws}; p0_prologue(F, a); }
    SEAM(0);
    if (IN(1)) GEMM_SWIGLU(WS_W1GU);
    SEAM(1);
    if (IN(2)) GEMM_F32(HB, WS_W1D, FF);
    SEAM(2);
    if (IN(3)) rowpass(F, Fm, x, args.out, args.in[3], 0.5f, args.in[7], XN);
    SEAM(3);
    if (IN(4)) GEMM_BF16(XN, WS_WIN, IN_PAD, D, PROJ);
    SEAM(4);
    if (IN(5)) { PrepArgs a{pos, args.in[17], args.in[19], args.in[10], args.in[11], ws}; prep_pass(F, a); }
    SEAM(5);
    if (IN(6)) { GEMM_BF16((const bf16*)(ws + WS_QLN), WS_WQB, QW, QLORA, Qb); GEMM_BF16((const bf16*)(ws + WS_KVLN), WS_WKVB, KVW, KVLORA, KVb); GEMM_BF16((const bf16*)(ws + WS_XC), WS_WLRU, 1024, LRU_W, GATES); }
    SEAM(6);
    if (IN(7)) { qrope_pass(F, ws); ScanArgs a{args.in[13], args.in[15], args.in[16], ws}; scan_pass1(F, a); }
    SEAM(7);
    if (IN(8)) { ScanArgs a{args.in[13], args.in[15], args.in[16], ws}; scan_pass2(F, a);
#if USE_MFMA_ATTN
        att::attn_phase((char*)lds + RING_OFF, F.vcu, F.G, Qb, KVb, (const bf16*)(ws + WS_KPE), Y);
#else
        attn_naive(F, ws);
#endif
    }
    SEAM(8);
    if (IN(9)) GEMM_F32(Y, WS_WOUT, D);
    SEAM(9);
    if (IN(10)) rowpass(F, Fm, args.out, args.out, args.in[8], 1.0f, args.in[22], XN);
    SEAM(10);
    if (IN(11)) GEMM_SWIGLU(WS_W2GU);
    SEAM(11);
    if (IN(12)) GEMM_F32(HB, WS_W2D, FF);
    SEAM(12);
    if (IN(13)) rowpass(F, Fm, args.out, args.out, args.in[23], 0.5f, nullptr, nullptr);
#undef IN
#undef SEAM
}

extern "C" void kernel_launch(void* const* d_in, const int* in_sizes, int n_in, void* d_out, int out_size, void* d_ws, size_t ws_size, hipStream_t stream) {
    static int grid = 0;
    if (grid == 0) {
        if (n_in != 27 || in_sizes[0] != M * D || out_size != M * D || ws_size < WS_END) { fprintf(stderr, "kernel_launch: unexpected shapes: n_in %d in0 %d out %d ws %zu (need %zu); nothing launched\n", n_in, n_in > 0 ? in_sizes[0] : -1, out_size, ws_size, (size_t)WS_END); grid = -1; return; }
        int dev = 0, cus = 0, per_cu = 0;
        if (hipGetDevice(&dev) != hipSuccess || hipDeviceGetAttribute(&cus, hipDeviceAttributeMultiprocessorCount, dev) != hipSuccess) { fprintf(stderr, "kernel_launch: device query failed\n"); grid = -1; return; }
        if (hipFuncSetAttribute((const void*)mega_fwd, hipFuncAttributeMaxDynamicSharedMemorySize, LDS_BYTES) != hipSuccess) { fprintf(stderr, "kernel_launch: hipFuncSetAttribute failed\n"); grid = -1; return; }
        if (hipOccupancyMaxActiveBlocksPerMultiprocessor(&per_cu, (const void*)mega_fwd, NWAVES * 64, LDS_BYTES) != hipSuccess || per_cu < 1)
            fprintf(stderr, "kernel_launch: note: occupancy query reports %d workgroups per CU\n", per_cu);
        (void)hipGetLastError();
        grid = cus;
    }
    if (grid < 0) return;
    if (hipMemsetAsync((char*)d_ws + WS_CTL, 0, CTL_ZERO_BYTES, stream) != hipSuccess) { fprintf(stderr, "kernel_launch: hipMemsetAsync failed\n"); return; }
    Args a{};
    for (int i = 0; i < 27; ++i) a.in[i] = (const float*)d_in[i];
    a.out = (float*)d_out; a.ws = (unsigned char*)d_ws;
#if MK_ONE_LAUNCH
    a.ph_lo = 0; a.ph_hi = N_PHASES; a.li = 0;
    hipLaunchKernelGGL(mega_fwd, dim3(grid), dim3(NWAVES * 64), LDS_BYTES, stream, a);
#else
    for (int li = 0; li < N_PHASES; ++li) { a.ph_lo = li; a.ph_hi = li + 1; a.li = li;
        hipLaunchKernelGGL(mega_fwd, dim3(grid), dim3(NWAVES * 64), LDS_BYTES, stream, a); }
#endif
    const hipError_t le = hipPeekAtLastError();
    if (le != hipSuccess) fprintf(stderr, "kernel_launch: launch failed: %s\n", hipGetErrorName(le));
}
```

```cpp
#include <hip/hip_runtime.h>
#include <cstdio>
#include <cstdint>
namespace pg8 {
#define PG8_LAS __attribute__((address_space(3)))
typedef unsigned short bf16_t;
typedef short bf16x8 __attribute__((ext_vector_type(8)));
typedef float f32x4 __attribute__((ext_vector_type(4)));
typedef unsigned u32x4 __attribute__((ext_vector_type(4)));
constexpr int BM = 256, BK = 64, HALF = 128, HTB = HALF * BK * 2  , STAGE_BYTES = 8 * HTB, NXCD = 8, WGM = 8;

__host__ __device__ __forceinline__ int lds_byte(int r, int c) { const int st = (r >> 4) * 2 + (c >> 5), rr = r & 15, cc = c & 31, ob = rr * 64 + cc * 2; return st * 1024 + (ob ^ (((ob >> 9) & 1) << 5)); }
__host__ __device__ __forceinline__ void stage_rc(int b, int& R, int& C) { const int st = b / 1024, sb = b % 1024, swz = sb ^ (((sb >> 9) & 1) << 5); R = (st >> 1) * 16 + swz / 64; C = (st & 1) * 32 + (swz % 64) / 2; }
__host__ __device__ __forceinline__ int perm32(int rho) { const int n = rho >> 4, i = rho & 15; return 8 * (i >> 2) + 4 * n + (i & 3); }

struct Unit { int pm, pn; };
struct Gemm { const bf16_t* A; const bf16_t* Bt; int M, N, K; };

struct StaticOrder {
    int nM, nN, nwg, G, c;
    __host__ __device__ void init(int M, int N, int G_, int c_) { nM = M / BM; nN = N / BM; nwg = nM * nN; G = G_; c = c_; }
    __host__ __device__ bool next(int i, Unit& u) const {
        const long L = (long)i * G + c; if (L >= nwg) return false;
        int wgid = (int)L; { const int q = nwg / NXCD, r = nwg % NXCD, xcd = wgid % NXCD, off = wgid / NXCD; wgid = (xcd < r ? xcd * (q + 1) : r * (q + 1) + (xcd - r) * q) + off; }
        const int nig = WGM * nN, gid = wgid / nig, fm = gid * WGM, gsz = (nM - fm) < WGM ? (nM - fm) : WGM;
        u.pm = fm + ((wgid % nig) % gsz); u.pn = (wgid % nig) / gsz; return true;
    }
    __device__ __forceinline__ void a_ready(const Unit&) const {}
    __device__ __forceinline__ void done(const Unit&) const {}
};

__device__ __forceinline__ unsigned cvt_pk_bf16(float lo, float hi) { unsigned r; asm volatile("v_cvt_pk_bf16_f32 %0, %1, %2" : "=v"(r) : "v"(lo), "v"(hi)); return r; }

struct EpiBf16 {
    static constexpr bool PERM = true, AFTER_DRAIN = false;
    bf16_t* O; int ldc;
    __device__ __forceinline__ void operator()(const f32x4 (&acc)[2][2][4][2], const Unit& u, int wr, int wc, int fr, int fq) const {
        const int row0 = u.pm * BM + wr * 64 + fr, col0 = u.pn * BM + wc * 32 + 8 * fq;
#pragma unroll
        for (int ai = 0; ai < 2; ++ai)
#pragma unroll
            for (int m = 0; m < 4; ++m) { bf16_t* rowp = O + (size_t)(row0 + ai * HALF + m * 16) * ldc + col0;
#pragma unroll
                for (int bj = 0; bj < 2; ++bj) { const f32x4 v0 = acc[ai][bj][m][0], v1 = acc[ai][bj][m][1];
                    u32x4 w; w.x = cvt_pk_bf16(v0[0], v0[1]); w.y = cvt_pk_bf16(v0[2], v0[3]); w.z = cvt_pk_bf16(v1[0], v1[1]); w.w = cvt_pk_bf16(v1[2], v1[3]);
                    *(u32x4*)(rowp + bj * HALF) = w; } }
    }
};
__device__ __forceinline__ float silu_mul(float g, float u) { return g * __builtin_amdgcn_rcpf(1.0f + __builtin_amdgcn_exp2f(-1.4426950408889634f * g)) * u; }
struct EpiSwiglu {
    static constexpr bool PERM = true, AFTER_DRAIN = false;
    bf16_t* O; int ldc;
    __device__ __forceinline__ void operator()(const f32x4 (&acc)[2][2][4][2], const Unit& u, int wr, int wc, int fr, int fq) const {
        const int row0 = u.pm * BM + wr * 64 + fr, col0 = u.pn * HALF + wc * 32 + 8 * fq;
#pragma unroll
        for (int ai = 0; ai < 2; ++ai)
#pragma unroll
            for (int m = 0; m < 4; ++m) { bf16_t* rowp = O + (size_t)(row0 + ai * HALF + m * 16) * ldc + col0;
                const f32x4 g0 = acc[ai][0][m][0], g1 = acc[ai][0][m][1], u0 = acc[ai][1][m][0], u1 = acc[ai][1][m][1];
                u32x4 w; w.x = cvt_pk_bf16(silu_mul(g0[0], u0[0]), silu_mul(g0[1], u0[1])); w.y = cvt_pk_bf16(silu_mul(g0[2], u0[2]), silu_mul(g0[3], u0[3]));
                w.z = cvt_pk_bf16(silu_mul(g1[0], u1[0]), silu_mul(g1[1], u1[1])); w.w = cvt_pk_bf16(silu_mul(g1[2], u1[2]), silu_mul(g1[3], u1[3]));
                *(u32x4*)rowp = w; }
    }
};
struct EpiF32 {
    static constexpr bool PERM = false, AFTER_DRAIN = false;
    float* C; int ldc;
    __device__ __forceinline__ void operator()(const f32x4 (&acc)[2][2][4][2], const Unit& u, int wr, int wc, int fr, int fq) const {
        const int row0 = u.pm * BM + wr * 64 + fr, col0 = u.pn * BM + wc * 32 + 4 * fq;
#pragma unroll
        for (int ai = 0; ai < 2; ++ai)
#pragma unroll
            for (int m = 0; m < 4; ++m) { float* rowp = C + (size_t)(row0 + ai * HALF + m * 16) * ldc + col0;
#pragma unroll
                for (int bj = 0; bj < 2; ++bj)
#pragma unroll
                    for (int n = 0; n < 2; ++n) *(f32x4*)(rowp + bj * HALF + n * 16) = acc[ai][bj][m][n]; }
    }
};

template <class Epi, class Sched, bool ALIGN_EPI = false, bool SP2 = false>
__device__ __forceinline__ void gemm_phase(PG8_LAS unsigned char* lds, const Gemm g, const Sched& S, const Epi& E) {
    const int tid = threadIdx.x, wid = __builtin_amdgcn_readfirstlane(tid >> 6), lane = tid & 63, wr = wid >> 2, wc = wid & 3, fr = lane & 15, fq = lane >> 4;
    const int K = g.K, nt = K / BK;
    unsigned voffA[2], voffB[2];
#pragma unroll
    for (int i = 0; i < 2; ++i) { int R, C; stage_rc(tid * 16 + i * 8192, R, C); const int Rb = Epi::PERM ? ((R & ~31) + perm32(R & 31)) : R;
        voffA[i] = (unsigned)(R * K + C) * 2u; voffB[i] = (unsigned)(Rb * K + C) * 2u; }
    const size_t kstep = (size_t)(BK * 2);
    const size_t hstep = (size_t)HALF * K * 2;
    const size_t tstep = 2 * hstep;
    const unsigned ldsw = (unsigned)wid * 1024u;
    const int aoff = lds_byte(wr * 64 + fr, fq * 8), boff = lds_byte(wc * 32 + fr, fq * 8);
#define PG8_SA(b, h) (((b) * 2 + (h)) * HTB)
#define PG8_SB(b, h) ((4 + (b) * 2 + (h)) * HTB)
#define PG8_STAGE(bufoff, gbase, voff) do { _Pragma("unroll") for (int _i = 0; _i < 2; ++_i) \
        __builtin_amdgcn_global_load_lds((const unsigned*)((const char*)(gbase) + (voff)[_i]), (PG8_LAS unsigned*)(lds + (bufoff) + ldsw + _i * 8192), 16, 0, 0); } while (0)
#define PG8_LDA(dst, b, h) do { _Pragma("unroll") for (int m = 0; m < 4; ++m) _Pragma("unroll") for (int k = 0; k < 2; ++k) dst[m][k] = *(const PG8_LAS bf16x8*)(lds + PG8_SA(b, h) + aoff + m * 2048 + k * 1024); } while (0)
#define PG8_LDB(dst, b, h) do { _Pragma("unroll") for (int n = 0; n < 2; ++n) _Pragma("unroll") for (int k = 0; k < 2; ++k) dst[n][k] = *(const PG8_LAS bf16x8*)(lds + PG8_SB(b, h) + boff + n * 2048 + k * 1024); } while (0)
#define PG8_MMA(ai, bj, At, Bt) do { __builtin_amdgcn_s_setprio(1); _Pragma("unroll") for (int m = 0; m < 4; ++m) _Pragma("unroll") for (int n = 0; n < 2; ++n) _Pragma("unroll") for (int k = 0; k < 2; ++k) \
        acc[ai][bj][m][n] = __builtin_amdgcn_mfma_f32_16x16x32_bf16(Bt[n][k], At[m][k], acc[ai][bj][m][n], 0, 0, 0); __builtin_amdgcn_s_setprio(0); } while (0)
#define PG8_WAIT_V(n) asm volatile("s_waitcnt vmcnt(" #n ")" ::: "memory")
#define PG8_WAIT_L(n) asm volatile("s_waitcnt lgkmcnt(" #n ")" ::: "memory")
#define PG8_BAR __builtin_amdgcn_s_barrier()
#define PG8_SCHED __builtin_amdgcn_sched_barrier(0)
    Unit cur, nxt; int ui = 0;
    if (!S.next(0, cur)) return;
    f32x4 acc[2][2][4][2];
#pragma unroll
    for (int a = 0; a < 2; ++a)
#pragma unroll
        for (int b = 0; b < 2; ++b)
#pragma unroll
            for (int m = 0; m < 4; ++m)
#pragma unroll
                for (int n = 0; n < 2; ++n) acc[a][b][m][n] = (f32x4){0.f, 0.f, 0.f, 0.f};
    bf16x8 At[4][2], B0[2][2], B1[2][2];
    const char* cA = (const char*)g.A + (size_t)cur.pm * tstep; const char* cB = (const char*)g.Bt + (size_t)cur.pn * tstep;
    S.a_ready(cur);
    if constexpr (SP2) {
        PG8_STAGE(PG8_SB(0, 0), cB, voffB); PG8_STAGE(PG8_SB(0, 1), cB + hstep, voffB); PG8_STAGE(PG8_SA(0, 0), cA, voffA); PG8_STAGE(PG8_SA(0, 1), cA + hstep, voffA);
        if (wr == 1) PG8_BAR;
        PG8_WAIT_V(2); PG8_BAR;
        PG8_STAGE(PG8_SB(1, 0), cB + kstep, voffB); PG8_STAGE(PG8_SA(1, 0), cA + kstep, voffA); PG8_STAGE(PG8_SB(1, 1), cB + hstep + kstep, voffB);
        PG8_WAIT_V(6); PG8_BAR;
    } else {
        PG8_STAGE(PG8_SB(0, 0), cB, voffB); PG8_STAGE(PG8_SA(0, 0), cA, voffA); PG8_STAGE(PG8_SB(0, 1), cB + hstep, voffB); PG8_STAGE(PG8_SA(0, 1), cA + hstep, voffA);
        if (wr == 1) PG8_BAR;
        PG8_WAIT_V(4); PG8_BAR;
        PG8_STAGE(PG8_SB(1, 0), cB + kstep, voffB); PG8_STAGE(PG8_SA(1, 0), cA + kstep, voffA); PG8_STAGE(PG8_SB(1, 1), cB + hstep + kstep, voffB);
        PG8_WAIT_V(6); PG8_BAR;
    }
    for (;;) {
        const bool has_next = S.next(ui + 1, nxt);
        const char* nA = has_next ? (const char*)g.A + (size_t)nxt.pm * tstep : cA; const char* nB = has_next ? (const char*)g.Bt + (size_t)nxt.pn * tstep : cB;
        for (int t = 0; t < nt; t += 2) {
            const bool last = (t == nt - 2);
            const char* a1 = cA + (size_t)(t + 1) * kstep;
            const char* a2 = last ? nA : cA + (size_t)(t + 2) * kstep; const char* b2 = last ? nB : cB + (size_t)(t + 2) * kstep;
            const char* a3 = a2 + kstep; const char* b3 = b2 + kstep;
            if (last && has_next) S.a_ready(nxt);
            if constexpr (SP2) {
            PG8_LDB(B0, 0, 0); PG8_LDB(B1, 0, 1); PG8_SCHED; PG8_LDA(At, 0, 0); PG8_STAGE(PG8_SA(1, 1), a1 + hstep, voffA);
            PG8_WAIT_V(8); PG8_WAIT_L(0); PG8_BAR; PG8_MMA(0, 0, At, B0); PG8_MMA(0, 1, At, B1); PG8_BAR; PG8_SCHED;
            PG8_LDA(At, 0, 1); PG8_STAGE(PG8_SB(0, 0), b2, voffB); PG8_STAGE(PG8_SB(0, 1), b2 + hstep, voffB); PG8_STAGE(PG8_SA(0, 0), a2, voffA);
            PG8_WAIT_V(8); PG8_WAIT_L(0); PG8_BAR; PG8_MMA(1, 0, At, B0); PG8_MMA(1, 1, At, B1); PG8_BAR; PG8_SCHED;
            PG8_LDB(B0, 1, 0); PG8_LDB(B1, 1, 1); PG8_SCHED; PG8_LDA(At, 1, 0); PG8_STAGE(PG8_SA(0, 1), a2 + hstep, voffA);
            PG8_WAIT_V(8); PG8_WAIT_L(0); PG8_BAR; PG8_MMA(0, 0, At, B0); PG8_MMA(0, 1, At, B1); PG8_BAR; PG8_SCHED;
            PG8_LDA(At, 1, 1); PG8_STAGE(PG8_SB(1, 0), b3, voffB); PG8_STAGE(PG8_SB(1, 1), b3 + hstep, voffB); PG8_STAGE(PG8_SA(1, 0), a3, voffA);
            PG8_WAIT_V(8); PG8_WAIT_L(0); PG8_BAR; PG8_MMA(1, 0, At, B0); PG8_MMA(1, 1, At, B1); PG8_BAR; PG8_SCHED;
            } else {
            PG8_LDB(B0, 0, 0); PG8_SCHED; PG8_LDA(At, 0, 0); PG8_STAGE(PG8_SA(1, 1), a1 + hstep, voffA);
            PG8_WAIT_L(8); PG8_BAR; PG8_WAIT_L(0); PG8_MMA(0, 0, At, B0); PG8_BAR; PG8_SCHED;
            PG8_LDB(B1, 0, 1); PG8_STAGE(PG8_SB(0, 0), b2, voffB);
            PG8_BAR; PG8_WAIT_L(0); PG8_MMA(0, 1, At, B1); PG8_BAR;
            PG8_LDA(At, 0, 1); PG8_STAGE(PG8_SA(0, 0), a2, voffA);
            PG8_BAR; PG8_WAIT_L(0); PG8_MMA(1, 0, At, B0); PG8_BAR; PG8_SCHED;
            PG8_STAGE(PG8_SB(0, 1), b2 + hstep, voffB);
            PG8_WAIT_V(6); PG8_BAR; PG8_MMA(1, 1, At, B1); PG8_BAR;
            PG8_LDB(B0, 1, 0); PG8_SCHED; PG8_LDA(At, 1, 0); PG8_STAGE(PG8_SA(0, 1), a2 + hstep, voffA);
            PG8_WAIT_L(8); PG8_BAR; PG8_WAIT_L(0); PG8_MMA(0, 0, At, B0); PG8_BAR; PG8_SCHED;
            PG8_LDB(B1, 1, 1); PG8_STAGE(PG8_SB(1, 0), b3, voffB);
            PG8_BAR; PG8_WAIT_L(0); PG8_MMA(0, 1, At, B1); PG8_BAR;
            PG8_LDA(At, 1, 1); PG8_STAGE(PG8_SA(1, 0), a3, voffA);
            PG8_BAR; PG8_WAIT_L(0); PG8_MMA(1, 0, At, B0); PG8_BAR; PG8_SCHED;
            PG8_STAGE(PG8_SB(1, 1), b3 + hstep, voffB);
            PG8_WAIT_V(6); PG8_BAR; PG8_MMA(1, 1, At, B1); PG8_BAR;
            }
        }
        if constexpr (ALIGN_EPI) { if (wr == 0) PG8_BAR; }
        if constexpr (!Epi::AFTER_DRAIN) { E(acc, cur, wr, wc, fr, fq); S.done(cur); }
        if (!has_next) break;
#pragma unroll
        for (int a = 0; a < 2; ++a)
#pragma unroll
            for (int b = 0; b < 2; ++b)
#pragma unroll
                for (int m = 0; m < 4; ++m)
#pragma unroll
                    for (int n = 0; n < 2; ++n) acc[a][b][m][n] = (f32x4){0.f, 0.f, 0.f, 0.f};
        cur = nxt; cA = nA; cB = nB; ++ui;
        if constexpr (ALIGN_EPI) { if (wr == 1) PG8_BAR; }
    }
    PG8_WAIT_V(0);
    if constexpr (!ALIGN_EPI) { if (wr == 0) PG8_BAR; }
    PG8_BAR;
    if constexpr (Epi::AFTER_DRAIN) { E.fused(acc, cur, wr, wc, fr, fq, lds, wid, lane); S.done(cur); }
#undef PG8_SA
#undef PG8_SB
#undef PG8_STAGE
#undef PG8_LDA
#undef PG8_LDB
#undef PG8_MMA
#undef PG8_WAIT_V
#undef PG8_WAIT_L
#undef PG8_BAR
#undef PG8_SCHED
}
}

#ifndef PG8_SP2
#define PG8_SP2 true
#endif
#ifndef PG8_ALIGN
#define PG8_ALIGN true
#endif

constexpr int NWAVES = 8;
#ifndef MK_ONE_LAUNCH
#define MK_ONE_LAUNCH 1
#endif
constexpr int N_PHASES = 14;

constexpr int BATCH = 8, SEQ = 4096, D = 1024, FF = 2816, M = BATCH * SEQ;
constexpr int LRU_W = 512, NHEAD = 8, QK_NOPE = 64, QK_ROPE = 32, VDIM = 64, QLORA = 384, KVLORA = 256;
constexpr int IN_COLS = 2 * LRU_W + QLORA + KVLORA + QK_ROPE;
constexpr int IN_PAD = 1792;
constexpr int QW = NHEAD * (QK_NOPE + QK_ROPE);
constexpr int KVW = NHEAD * (QK_NOPE + VDIM);
constexpr int C_QLAT = 2 * LRU_W, C_KVLAT = C_QLAT + QLORA, C_KROPE = C_KVLAT + KVLORA;
constexpr float EPS = 1e-6f;
constexpr float QSCALE = 0.14724445f;
constexpr int NCHUNK = SEQ / 64;

constexpr size_t MiB = 1u << 20;
constexpr size_t WS_CTL = 0, CTL_ZERO_BYTES = 1 * MiB;
constexpr size_t WS_W1GU = 2 * MiB, WS_W1D = 13 * MiB, WS_W2GU = 19 * MiB, WS_W2D = 30 * MiB, WS_WIN = 36 * MiB, WS_WQB = 40 * MiB, WS_WKVB = 41 * MiB, WS_WLRU = 42 * MiB, WS_WOUT = 43 * MiB;
constexpr size_t WS_XN = 48 * MiB;
constexpr size_t WS_QLN = 48 * MiB, WS_KVLN = 72 * MiB;
constexpr size_t WS_Y = 48 * MiB;
constexpr size_t WS_HB = 112 * MiB;
constexpr size_t WS_PROJ = 112 * MiB, WS_GATES = 224 * MiB;
constexpr size_t WS_F = 288 * MiB;
constexpr size_t WS_Q = 288 * MiB, WS_KV = 336 * MiB;
constexpr size_t WS_KPE = 416 * MiB, WS_COS = 418 * MiB, WS_SIN = 420 * MiB, WS_AGG = 422 * MiB;
constexpr size_t WS_XC = 424 * MiB;
constexpr size_t WS_END = 456 * MiB;
constexpr int CW_TMO = 0, CW_CODE = 1;
constexpr int CW_BAR = 4096;

constexpr int RING_OFF = 0, RING_BYTES = 131072;
constexpr int LDSCTL_OFF = RING_BYTES, MISC_OFF = LDSCTL_OFF + 320;
constexpr int LDS_BYTES = 147456;

#define GAS __attribute__((address_space(1)))
#define LAS __attribute__((address_space(3)))
typedef unsigned short bf16;
typedef unsigned v4u __attribute__((ext_vector_type(4)));
typedef float f32x4 __attribute__((ext_vector_type(4)));
typedef short bf16x8 __attribute__((ext_vector_type(8)));
typedef GAS unsigned gu32;
typedef GAS unsigned long long gu64;
#define RLX_AGENT __ATOMIC_RELAXED, __HIP_MEMORY_SCOPE_AGENT
#define LDS_WAIT() asm volatile("s_waitcnt lgkmcnt(0)" ::: "memory")
#define VM_WAIT() asm volatile("s_waitcnt vmcnt(0)" ::: "memory")
__device__ __forceinline__ unsigned long long rt() { return __builtin_amdgcn_s_memrealtime(); }
__device__ __forceinline__ unsigned f2bf(float f) { unsigned u = __builtin_bit_cast(unsigned, f); return (u + 0x7fffu + ((u >> 16) & 1u)) >> 16; }
__device__ __forceinline__ unsigned pk2(float lo, float hi) { return f2bf(lo) | (f2bf(hi) << 16); }

#define XB_TMO      128
#define XB_XCNT(j)  (256  + 64 * (j))
#define XB_XSUB(j)  (1280 + 64 * (j))
#define XB_XGEN(j)  (2304 + 64 * (j))
#define XB_TOP      3328
#define XB_TOPGEN   3392
#define XCD_BAR_WORDS 3456
#define XB_SPIN_CAP (1u << 18)

__device__ __forceinline__ unsigned xb_ld(unsigned* p)              { return __hip_atomic_load(p, __ATOMIC_RELAXED, __HIP_MEMORY_SCOPE_AGENT); }
__device__ __forceinline__ unsigned xb_add(unsigned* p, unsigned v) { return __hip_atomic_fetch_add(p, v, __ATOMIC_RELAXED, __HIP_MEMORY_SCOPE_AGENT); }
__device__ __forceinline__ unsigned xb_xcc_id() { return (unsigned)__builtin_amdgcn_s_getreg((3 << 11) | 20) & 0xFu; }
#define XB_SPIN(cond, bar) do { unsigned _sp = 0; while (cond) { __builtin_amdgcn_s_sleep(1); \
    if ((++_sp & 255u) == 0u) { if (xb_ld(&(bar)[XB_TMO])) break; if (_sp > XB_SPIN_CAP) { atomicAdd(&(bar)[XB_TMO], 1u); break; } } } } while (0)

struct XcdBarrier {
    unsigned* bar; unsigned x;
    volatile LAS unsigned* st;
};

__device__ __forceinline__ XcdBarrier xcd_barrier_post(unsigned* bar, volatile LAS unsigned* st) {
    XcdBarrier b; b.bar = bar; b.x = xb_xcc_id(); b.st = st;
    if (threadIdx.x == 0) (void)xb_add(&bar[XB_XCNT(b.x)], 1u);
    return b;
}
__device__ __forceinline__ void xcd_barrier_complete(unsigned* bar, unsigned x, unsigned& nloc, unsigned& nx) {
    const unsigned G = gridDim.x * gridDim.y * gridDim.z;
    unsigned sum, cnt, mine, sp = 0u;
    for (;;) {
        sum = 0u; cnt = 0u; mine = 0u;
#pragma unroll
        for (unsigned j = 0; j < 16; ++j) { const unsigned c = xb_ld(&bar[XB_XCNT(j)]); sum += c; cnt += (c > 0u) ? 1u : 0u; mine = (j == x) ? c : mine; }
        if (sum == G) break;
        __builtin_amdgcn_s_sleep(1);
        if ((++sp & 255u) == 0u) { if (xb_ld(&bar[XB_TMO])) break; if (sp > XB_SPIN_CAP) { atomicAdd(&bar[XB_TMO], 1u); break; } }
    }
    nloc = mine > 0u ? mine : 1u; nx = cnt > 0u ? cnt : 1u;
}

__device__ __forceinline__ void xcd_barrier(const XcdBarrier& b) {
    asm volatile("s_waitcnt vmcnt(0)" ::: "memory");
    __syncthreads();
    if (threadIdx.x == 0) {
        unsigned* bar = b.bar;
        __builtin_amdgcn_s_waitcnt(0);
        unsigned nloc = b.st[0], nx = b.st[1];
        if (nloc == 0u) { xcd_barrier_complete(bar, b.x, nloc, nx); b.st[0] = nloc; b.st[1] = nx; }
        const unsigned old = xb_add(&bar[XB_XSUB(b.x)], 1u);
        const unsigned gen = old / nloc;
        if (old + 1u == (gen + 1u) * nloc) {
            __builtin_amdgcn_fence(__ATOMIC_RELEASE, "agent");
            asm volatile("s_waitcnt vmcnt(0)" ::: "memory");
            const unsigned og = xb_add(&bar[XB_TOP], 1u);
            const unsigned tg = og / nx;
            if (og + 1u == (tg + 1u) * nx) xb_add(&bar[XB_TOPGEN], 1u);
            else XB_SPIN(xb_ld(&bar[XB_TOPGEN]) == tg, bar);
            __builtin_amdgcn_fence(__ATOMIC_ACQUIRE, "agent");
            xb_add(&bar[XB_XGEN(b.x)], 1u);
            asm volatile("s_waitcnt vmcnt(0)" ::: "memory");
        } else {
            XB_SPIN(xb_ld(&bar[XB_XGEN(b.x)]) == gen, bar);
            __builtin_amdgcn_fence(__ATOMIC_ACQUIRE, "agent");
            asm volatile("s_waitcnt vmcnt(0)" ::: "memory");
        }
    }
    __syncthreads();
}

struct Frame {
    LAS unsigned char* lds;
    volatile LAS unsigned* MISC;
    gu32* ctl;
    int tid, lane, wave;
    int vcu, G;
};
__device__ __forceinline__ float bf2f(unsigned short u) { return __builtin_bit_cast(float, (unsigned)u << 16); }
__device__ __forceinline__ float bflo(unsigned w) { return __builtin_bit_cast(float, w << 16); }
__device__ __forceinline__ float bfhi(unsigned w) { return __builtin_bit_cast(float, w & 0xffff0000u); }
__device__ __forceinline__ float wave_sum(float v) {
#pragma unroll
    for (int o = 1; o < 64; o <<= 1) v += __shfl_xor(v, o);
    return v;
}
__device__ __forceinline__ float fexp(float x) { return __builtin_amdgcn_exp2f(x * 1.4426950408889634f); }
__device__ __forceinline__ float sigmoidf_(float z) { return __builtin_amdgcn_rcpf(1.0f + fexp(-z)); }
__device__ __forceinline__ float gelu_tanh(float x) {
    const float z = 0.7978845608028654f * (x + 0.044715f * x * x * x);
    const float t = 1.0f - 2.0f * __builtin_amdgcn_rcpf(fexp(2.0f * z) + 1.0f);
    return 0.5f * x * (1.0f + t);
}
__device__ __constant__ float INV_FREQ[16] = {1.000000000e+00f, 5.623413324e-01f, 3.162277639e-01f, 1.778279394e-01f, 1.000000015e-01f, 5.623412877e-02f, 3.162277862e-02f, 1.778279431e-02f,
                                              9.999999776e-03f, 5.623413250e-03f, 3.162277862e-03f, 1.778279431e-03f, 1.000000047e-03f, 5.623413017e-04f, 3.162277862e-04f, 1.778279402e-04f};

__device__ __forceinline__ void p0_transpose_item(const float* W, int K, int N, bf16* WT, int dst_row0, LAS float* scr, int k0, int n0, int lane) {
#pragma unroll 8
    for (int i = 0; i < 32; ++i) { const int kk = 2 * i + (lane >> 5); scr[kk * 33 + (lane & 31)] = W[(size_t)(k0 + kk) * N + n0 + (lane & 31)]; }
    LDS_WAIT(); asm volatile("" ::: "memory");
    const int c = lane & 7;
#pragma unroll
    for (int j = 0; j < 4; ++j) { const int n = (lane >> 3) + 8 * j; const LAS float* s = scr + (8 * c) * 33 + n;
        v4u o; o.x = pk2(s[0 * 33], s[1 * 33]); o.y = pk2(s[2 * 33], s[3 * 33]); o.z = pk2(s[4 * 33], s[5 * 33]); o.w = pk2(s[6 * 33], s[7 * 33]);
        *(GAS v4u*)(WT + (size_t)(dst_row0 + n) * K + k0 + 8 * c) = o; }
    LDS_WAIT(); asm volatile("" ::: "memory");
}
__device__ __forceinline__ void rms_row_to_bf16(int lane, const float* xrow, const float* g, bf16* orow) {
    const GAS f32x4* xr = (const GAS f32x4*)xrow + lane; const GAS f32x4* gr = (const GAS f32x4*)g + lane;
    f32x4 v[4]; float s = 0.f;
#pragma unroll
    for (int j = 0; j < 4; ++j) { v[j] = xr[64 * j]; s += (v[j].x * v[j].x + v[j].y * v[j].y) + (v[j].z * v[j].z + v[j].w * v[j].w); }
    const float rinv = 1.0f / sqrtf(wave_sum(s) * (1.f / D) + EPS);
    GAS unsigned long long* o8 = (GAS unsigned long long*)orow + lane;
#pragma unroll
    for (int j = 0; j < 4; ++j) { const f32x4 gg = gr[64 * j]; o8[64 * j] = (unsigned long long)pk2(v[j].x * rinv * gg.x, v[j].y * rinv * gg.y) | ((unsigned long long)pk2(v[j].z * rinv * gg.z, v[j].w * rinv * gg.w) << 32); }
}
struct P0Args { const float *x, *g1, *w1g, *w1u, *w1d, *w2g, *w2u, *w2d, *win, *wqb, *wkvb, *wout, *wla, *wlx; unsigned char* ws; };
__device__ __forceinline__ void p0_prologue(Frame& F, const P0Args& a) {
    LAS float* scr = (LAS float*)(F.lds + RING_OFF + F.wave * 16384);
    const int gw = F.vcu * NWAVES + F.wave, NGW = F.G * NWAVES;
    bf16* W1GU = (bf16*)(a.ws + WS_W1GU); bf16* W1D = (bf16*)(a.ws + WS_W1D); bf16* W2GU = (bf16*)(a.ws + WS_W2GU); bf16* W2D = (bf16*)(a.ws + WS_W2D);
    bf16* WIN = (bf16*)(a.ws + WS_WIN); bf16* WQB = (bf16*)(a.ws + WS_WQB); bf16* WKVB = (bf16*)(a.ws + WS_WKVB); bf16* WLRU = (bf16*)(a.ws + WS_WLRU); bf16* WOUT = (bf16*)(a.ws + WS_WOUT);
    constexpr int I_GU = (D / 64) * (FF / 32), I_DN = (FF / 64) * (D / 32), I_IN = (D / 64) * (IN_COLS / 32), I_QB = (QLORA / 64) * (QW / 32), I_KVB = (KVLORA / 64) * (KVW / 32), I_OUT = (D / 64) * (D / 32);
    constexpr int NITEMS = 4 * I_GU + 2 * I_DN + I_IN + I_QB + I_KVB + I_OUT;
    for (int it = gw; it < NITEMS; it += NGW) {
        int r = it;
        if (r < 4 * I_GU) {
            const int which = r / I_GU; r -= which * I_GU; const int nblk = FF / 32, kb = r / nblk, nb = r % nblk, n0 = 32 * nb;
            const float* W = which == 0 ? a.w1g : which == 1 ? a.w1u : which == 2 ? a.w2g : a.w2u; bf16* WT = which < 2 ? W1GU : W2GU;
            p0_transpose_item(W, D, FF, WT, 256 * (n0 / 128) + 128 * (which & 1) + (n0 % 128), scr, 64 * kb, n0, F.lane); continue; }
        r -= 4 * I_GU;
        if (r < 2 * I_DN) { const int which = r / I_DN; r -= which * I_DN; const int nblk = D / 32, kb = r / nblk, nb = r % nblk;
            p0_transpose_item(which ? a.w2d : a.w1d, FF, D, which ? W2D : W1D, 32 * nb, scr, 64 * kb, 32 * nb, F.lane); continue; }
        r -= 2 * I_DN;
        if (r < I_IN) { const int nblk = IN_COLS / 32, kb = r / nblk, nb = r % nblk; p0_transpose_item(a.win, D, IN_COLS, WIN, 32 * nb, scr, 64 * kb, 32 * nb, F.lane); continue; }
        r -= I_IN;
        if (r < I_QB) { const int nblk = QW / 32, kb = r / nblk, nb = r % nblk; p0_transpose_item(a.wqb, QLORA, QW, WQB, 32 * nb, scr, 64 * kb, 32 * nb, F.lane); continue; }
        r -= I_QB;
        if (r < I_KVB) { const int nblk = KVW / 32, kb = r / nblk, nb = r % nblk; p0_transpose_item(a.wkvb, KVLORA, KVW, WKVB, 32 * nb, scr, 64 * kb, 32 * nb, F.lane); continue; }
        r -= I_KVB;
        { const int nblk = D / 32, kb = r / nblk, nb = r % nblk; p0_transpose_item(a.wout, D, D, WOUT, 32 * nb, scr, 64 * kb, 32 * nb, F.lane); }
    }
    { const int gt = (F.vcu * NWAVES + F.wave) * 64 + F.lane, NGT = NGW * 64; GAS unsigned* p = (GAS unsigned*)(WIN + (size_t)IN_COLS * D);
      for (int i = gt; i < (IN_PAD - IN_COLS) * D / 2; i += NGT) p[i] = 0u; }
    { const int gt = (F.vcu * NWAVES + F.wave) * 64 + F.lane, NGT = NGW * 64; GAS unsigned* p = (GAS unsigned*)WLRU;
      for (int i = gt; i < 1024 * 512 / 2; i += NGT) { const int np = i / 256, k = (i % 256) * 2; const int half = np >> 9, c = np & 511, blk = c >> 6, e = c & 63, kb = k >> 6, d = k & 63;
          const float* w = half ? a.wlx : a.wla; unsigned o = 0u; if (kb == blk) o = pk2(w[blk * 4096 + d * 64 + e], w[blk * 4096 + (d + 1) * 64 + e]); p[i] = o; } }
    bf16* XN = (bf16*)(a.ws + WS_XN);
    for (int m = gw; m < M; m += NGW) rms_row_to_bf16(F.lane, a.x + (size_t)m * D, a.g1, XN + (size_t)m * D);
}

__device__ __forceinline__ void rowpass(Frame& F, const float* Fm, const float* base, float* out, const float* g_post, float coef, const float* g_next, bf16* XN) {
    const int gw = F.vcu * NWAVES + F.wave, NGW = F.G * NWAVES, lane = F.lane;
    for (int m = gw; m < M; m += NGW) {
        const GAS f32x4* fr = (const GAS f32x4*)(Fm + (size_t)m * D) + lane; const GAS f32x4* br = (const GAS f32x4*)(base + (size_t)m * D) + lane;
        const GAS f32x4* gp = (const GAS f32x4*)g_post + lane;
        f32x4 v[4], b[4]; float s = 0.f;
#pragma unroll
        for (int j = 0; j < 4; ++j) { v[j] = fr[64 * j]; b[j] = br[64 * j]; s += (v[j].x * v[j].x + v[j].y * v[j].y) + (v[j].z * v[j].z + v[j].w * v[j].w); }
        const float rinv = coef / sqrtf(wave_sum(s) * (1.f / D) + EPS);
        float s2 = 0.f;
#pragma unroll
        for (int j = 0; j < 4; ++j) { const f32x4 gg = gp[64 * j]; v[j] = b[j] + v[j] * rinv * gg; s2 += (v[j].x * v[j].x + v[j].y * v[j].y) + (v[j].z * v[j].z + v[j].w * v[j].w); }
        GAS f32x4* orow = (GAS f32x4*)(out + (size_t)m * D) + lane;
#pragma unroll
        for (int j = 0; j < 4; ++j) orow[64 * j] = v[j];
        if (XN) {
            const float r2 = 1.0f / sqrtf(wave_sum(s2) * (1.f / D) + EPS); const GAS f32x4* gn = (const GAS f32x4*)g_next + lane;
            GAS unsigned long long* o8 = (GAS unsigned long long*)(XN + (size_t)m * D) + lane;
#pragma unroll
            for (int j = 0; j < 4; ++j) { const f32x4 gg = gn[64 * j]; o8[64 * j] = (unsigned long long)pk2(v[j].x * r2 * gg.x, v[j].y * r2 * gg.y) | ((unsigned long long)pk2(v[j].z * r2 * gg.z, v[j].w * r2 * gg.w) << 32); }
        }
    }
}

struct PrepArgs { const int* pos; const float *gq, *gkv, *cw, *cb; unsigned char* ws; };
__device__ __forceinline__ void prep_pass(Frame& F, const PrepArgs& a) {
    const int gw = F.vcu * NWAVES + F.wave, NGW = F.G * NWAVES, lane = F.lane;
    const bf16* PROJ = (const bf16*)(a.ws + WS_PROJ); bf16* QLN = (bf16*)(a.ws + WS_QLN); bf16* KVLN = (bf16*)(a.ws + WS_KVLN); bf16* KPE = (bf16*)(a.ws + WS_KPE);
    float* COS = (float*)(a.ws + WS_COS); float* SIN = (float*)(a.ws + WS_SIN); bf16* XC = (bf16*)(a.ws + WS_XC);
    for (int m = gw; m < M; m += NGW) {
        const bf16* pr = PROJ + (size_t)m * IN_PAD;
        {
            const GAS unsigned* p = (const GAS unsigned*)(pr + C_QLAT + lane * 6); const unsigned w0 = p[0], w1 = p[1], w2 = p[2];
            float v[6] = {bflo(w0), bfhi(w0), bflo(w1), bfhi(w1), bflo(w2), bfhi(w2)}; float s = 0.f;
#pragma unroll
            for (int j = 0; j < 6; ++j) s += v[j] * v[j];
            const float rinv = 1.0f / sqrtf(wave_sum(s) * (1.f / QLORA) + EPS); const float* g = a.gq + lane * 6;
            GAS unsigned* o = (GAS unsigned*)(QLN + (size_t)m * QLORA + lane * 6);
            o[0] = pk2(v[0] * rinv * g[0], v[1] * rinv * g[1]); o[1] = pk2(v[2] * rinv * g[2], v[3] * rinv * g[3]); o[2] = pk2(v[4] * rinv * g[4], v[5] * rinv * g[5]);
        }
        {
            const GAS unsigned* p = (const GAS unsigned*)(pr + C_KVLAT + lane * 4); const unsigned w0 = p[0], w1 = p[1];
            float v[4] = {bflo(w0), bfhi(w0), bflo(w1), bfhi(w1)}; float s = (v[0] * v[0] + v[1] * v[1]) + (v[2] * v[2] + v[3] * v[3]);
            const float rinv = 1.0f / sqrtf(wave_sum(s) * (1.f / KVLORA) + EPS); const float* g = a.gkv + lane * 4;
            GAS unsigned* o = (GAS unsigned*)(KVLN + (size_t)m * KVLORA + lane * 4);
            o[0] = pk2(v[0] * rinv * g[0], v[1] * rinv * g[1]); o[1] = pk2(v[2] * rinv * g[2], v[3] * rinv * g[3]);
        }
        if (lane < 16) {
            const float x1 = bf2f(pr[C_KROPE + lane]), x2 = bf2f(pr[C_KROPE + 16 + lane]);
            const float ang = (float)a.pos[m] * INV_FREQ[lane];
            double rev = (double)ang * 0.15915494309189535; rev -= __builtin_rint(rev); const float fr = (float)rev;
            const float sn = __builtin_amdgcn_sinf(fr), cs = __builtin_amdgcn_cosf(fr);
            KPE[(size_t)m * 32 + lane] = (bf16)f2bf(x1 * cs - x2 * sn); KPE[(size_t)m * 32 + 16 + lane] = (bf16)f2bf(x2 * cs + x1 * sn);
            COS[(size_t)m * 16 + lane] = cs; SIN[(size_t)m * 16 + lane] = sn;
        }
        {
            const int t = m % SEQ; float acc[8];
#pragma unroll
            for (int j = 0; j < 8; ++j) acc[j] = a.cb[lane * 8 + j];
#pragma unroll
            for (int k = 0; k < 4; ++k) { const int tt = t - 3 + k; if (tt >= 0) {
                const v4u w = *(const GAS v4u*)(PROJ + (size_t)(m - 3 + k) * IN_PAD + lane * 8); const float* cwk = a.cw + k * LRU_W + lane * 8;
                acc[0] += cwk[0] * bflo(w.x); acc[1] += cwk[1] * bfhi(w.x); acc[2] += cwk[2] * bflo(w.y); acc[3] += cwk[3] * bfhi(w.y);
                acc[4] += cwk[4] * bflo(w.z); acc[5] += cwk[5] * bfhi(w.z); acc[6] += cwk[6] * bflo(w.w); acc[7] += cwk[7] * bfhi(w.w); } }
            v4u o; o.x = pk2(acc[0], acc[1]); o.y = pk2(acc[2], acc[3]); o.z = pk2(acc[4], acc[5]); o.w = pk2(acc[6], acc[7]);
            *(GAS v4u*)(XC + (size_t)m * LRU_W + lane * 8) = o;
        }
    }
}

__device__ __forceinline__ void qrope_pass(Frame& F, unsigned char* ws) {
    const int gw = F.vcu * NWAVES + F.wave, NGW = F.G * NWAVES, lane = F.lane;
    bf16* Q = (bf16*)(ws + WS_Q); const float* COS = (const float*)(ws + WS_COS); const float* SIN = (const float*)(ws + WS_SIN);
    for (int m = gw; m < M; m += NGW) {
        bf16* q = Q + (size_t)m * QW;
#pragma unroll
        for (int pp = 0; pp < 2; ++pp) { const int p = lane + 64 * pp, h = p >> 4, i = p & 15; bf16* qa = q + h * 96 + 64 + i;
            const float x1 = bf2f(qa[0]), x2 = bf2f(qa[16]); const float cs = COS[(size_t)m * 16 + i], sn = SIN[(size_t)m * 16 + i];
            qa[0] = (bf16)f2bf((x1 * cs - x2 * sn) * QSCALE); qa[16] = (bf16)f2bf((x2 * cs + x1 * sn) * QSCALE); }
        {
            GAS v4u* p = (GAS v4u*)(q + (lane >> 3) * 96 + (lane & 7) * 8); const v4u w = *p; v4u o;
            o.x = pk2(bflo(w.x) * QSCALE, bfhi(w.x) * QSCALE); o.y = pk2(bflo(w.y) * QSCALE, bfhi(w.y) * QSCALE); o.z = pk2(bflo(w.z) * QSCALE, bfhi(w.z) * QSCALE); o.w = pk2(bflo(w.w) * QSCALE, bfhi(w.w) * QSCALE);
            *p = o; }
    }
}

struct LruCh { float ba, bx, sp8; };
__device__ __forceinline__ LruCh lru_channel(const float* ba, const float* bx, const float* lam, int c) {
    LruCh r; r.ba = ba[c]; r.bx = bx[c]; const float y = fexp(-lam[c]);
    const float sp = (y > 0.05f) ? __logf(1.0f + y) : y * (1.0f + y * (-0.5f + y * (0.33333333f + y * (-0.25f + y * 0.2f))));
    r.sp8 = 8.0f * sp; return r;
}
__device__ __forceinline__ void lru_au(const LruCh& ch, float rpre, float ipre, float xc, float& a, float& u) {
    const float r = sigmoidf_(rpre + ch.ba), ig = sigmoidf_(ipre + ch.bx);
    const float la = -ch.sp8 * r; a = fexp(la);
    const float x = 2.0f * la;
    const float em = (x > -0.25f) ? -x * (1.0f + x * (0.5f + x * (0.16666667f + x * (0.041666667f + x * (0.0083333333f + x * 0.0013888889f))))) : 1.0f - fexp(x);
    u = sqrtf(em) * (ig * xc);
}
struct ScanArgs { const float *ba, *bx, *lam; unsigned char* ws; };
__device__ __forceinline__ void scan_pass1(Frame& F, const ScanArgs& a) {
    const bf16* GATES = (const bf16*)(a.ws + WS_GATES); const bf16* XC = (const bf16*)(a.ws + WS_XC); float* AGG = (float*)(a.ws + WS_AGG);
    const int gw = F.vcu * NWAVES + F.wave, NGW = F.G * NWAVES;
    for (int item = gw; item < BATCH * NCHUNK * 4; item += NGW) {
        const int cu = item >> 2, c0 = (item & 3) * 128 + F.lane * 2;
        const LruCh ch0 = lru_channel(a.ba, a.bx, a.lam, c0), ch1 = lru_channel(a.ba, a.bx, a.lam, c0 + 1);
        const GAS unsigned* gr = (const GAS unsigned*)(GATES + (size_t)cu * 64 * 1024 + c0); const GAS unsigned* gx = (const GAS unsigned*)(XC + (size_t)cu * 64 * LRU_W + c0);
        float A0 = 1.0f, H0 = 0.0f, A1 = 1.0f, H1 = 0.0f;
#pragma unroll 8
        for (int t = 0; t < 64; ++t) { const unsigned wr_ = gr[t * 512], wi_ = gr[t * 512 + 256], wx_ = gx[t * 256]; float a0, u0, a1, u1;
            lru_au(ch0, bflo(wr_), bflo(wi_), bflo(wx_), a0, u0); lru_au(ch1, bfhi(wr_), bfhi(wi_), bfhi(wx_), a1, u1);
            A0 *= a0; H0 = a0 * H0 + u0; A1 *= a1; H1 = a1 * H1 + u1; }
        *(GAS f32x4*)(AGG + ((size_t)cu * LRU_W + c0) * 2) = (f32x4){A0, H0, A1, H1};
    }
}
__device__ __forceinline__ void scan_pass2(Frame& F, const ScanArgs& a) {
    const bf16* GATES = (const bf16*)(a.ws + WS_GATES); const bf16* XC = (const bf16*)(a.ws + WS_XC); const float* AGG = (const float*)(a.ws + WS_AGG);
    const bf16* PROJ = (const bf16*)(a.ws + WS_PROJ); bf16* Y = (bf16*)(a.ws + WS_Y);
    const int gw = F.vcu * NWAVES + F.wave, NGW = F.G * NWAVES;
    for (int item = gw; item < BATCH * NCHUNK * 4; item += NGW) {
        const int cu = item >> 2, c0 = (item & 3) * 128 + F.lane * 2; const int b = cu / NCHUNK, ci = cu % NCHUNK;
        const LruCh ch0 = lru_channel(a.ba, a.bx, a.lam, c0), ch1 = lru_channel(a.ba, a.bx, a.lam, c0 + 1);
        float h0 = 0.0f, h1 = 0.0f;
        { const GAS f32x4* ag = (const GAS f32x4*)(AGG + ((size_t)b * NCHUNK * LRU_W + c0) * 2);
#pragma unroll 8
          for (int j = 0; j < ci; ++j) { const f32x4 v = ag[(size_t)j * (LRU_W / 2)]; h0 = v.x * h0 + v.y; h1 = v.z * h1 + v.w; } }
        const GAS unsigned* gr = (const GAS unsigned*)(GATES + (size_t)cu * 64 * 1024 + c0); const GAS unsigned* gx = (const GAS unsigned*)(XC + (size_t)cu * 64 * LRU_W + c0);
        const GAS unsigned* gg = (const GAS unsigned*)(PROJ + (size_t)cu * 64 * IN_PAD + LRU_W + c0); GAS unsigned* yo = (GAS unsigned*)(Y + (size_t)cu * 64 * D + c0);
#pragma unroll 8
        for (int t = 0; t < 64; ++t) { const unsigned wr_ = gr[t * 512], wi_ = gr[t * 512 + 256], wx_ = gx[t * 256], wg_ = gg[t * (IN_PAD / 2)]; float a0, u0, a1, u1;
            lru_au(ch0, bflo(wr_), bflo(wi_), bflo(wx_), a0, u0); lru_au(ch1, bfhi(wr_), bfhi(wi_), bfhi(wx_), a1, u1);
            h0 = a0 * h0 + u0; h1 = a1 * h1 + u1;
            yo[t * (D / 2)] = pk2(h0 * gelu_tanh(bflo(wg_)), h1 * gelu_tanh(bfhi(wg_))); }
    }
}

__device__ __forceinline__ void attn_naive(Frame& F, unsigned char* ws) {
    const bf16* Q = (const bf16*)(ws + WS_Q); const bf16* KV = (const bf16*)(ws + WS_KV); const bf16* KPE = (const bf16*)(ws + WS_KPE); bf16* Y = (bf16*)(ws + WS_Y);
    for (int u = F.vcu; u < 512; u += F.G) {
        const int uu = u & 255, bh = uu >> 2, qb = (u < 256) ? (uu & 3) : 7 - (uu & 3); const int b = bh >> 3, h = bh & 7;
        const int t = qb * 512 + F.tid; const size_t row = (size_t)b * SEQ + t;
        float q[96], o[64];
        { const GAS v4u* qp = (const GAS v4u*)(Q + row * QW + h * 96);
#pragma unroll
          for (int j = 0; j < 12; ++j) { const v4u w = qp[j]; q[8 * j] = bflo(w.x); q[8 * j + 1] = bfhi(w.x); q[8 * j + 2] = bflo(w.y); q[8 * j + 3] = bfhi(w.y); q[8 * j + 4] = bflo(w.z); q[8 * j + 5] = bfhi(w.z); q[8 * j + 6] = bflo(w.w); q[8 * j + 7] = bfhi(w.w); } }
#pragma unroll
        for (int d = 0; d < 64; ++d) o[d] = 0.f;
        float mx = -1e30f, l = 0.f;
        const int nk = __builtin_amdgcn_readfirstlane(((t >> 6) + 1) << 6);
        for (int j = 0; j < nk; ++j) {
            const size_t kr = (size_t)b * SEQ + j; const GAS v4u* kn = (const GAS v4u*)(KV + kr * KVW + h * 128); const GAS v4u* kp = (const GAS v4u*)(KPE + kr * 32);
            float s = 0.f;
#pragma unroll
            for (int jj = 0; jj < 8; ++jj) { const v4u w = kn[jj]; s += q[8 * jj] * bflo(w.x) + q[8 * jj + 1] * bfhi(w.x) + q[8 * jj + 2] * bflo(w.y) + q[8 * jj + 3] * bfhi(w.y) + q[8 * jj + 4] * bflo(w.z) + q[8 * jj + 5] * bfhi(w.z) + q[8 * jj + 6] * bflo(w.w) + q[8 * jj + 7] * bfhi(w.w); }
#pragma unroll
            for (int jj = 0; jj < 4; ++jj) { const v4u w = kp[jj]; s += q[64 + 8 * jj] * bflo(w.x) + q[64 + 8 * jj + 1] * bfhi(w.x) + q[64 + 8 * jj + 2] * bflo(w.y) + q[64 + 8 * jj + 3] * bfhi(w.y) + q[64 + 8 * jj + 4] * bflo(w.z) + q[64 + 8 * jj + 5] * bfhi(w.z) + q[64 + 8 * jj + 6] * bflo(w.w) + q[64 + 8 * jj + 7] * bfhi(w.w); }
            const float mn = fmaxf(mx, s), al = __builtin_amdgcn_exp2f(mx - mn), p = __builtin_amdgcn_exp2f(s - mn); mx = mn; l = l * al + p;
#pragma unroll
            for (int jj = 0; jj < 8; ++jj) { const v4u w = kn[8 + jj];
                o[8 * jj] = o[8 * jj] * al + p * bflo(w.x); o[8 * jj + 1] = o[8 * jj + 1] * al + p * bfhi(w.x); o[8 * jj + 2] = o[8 * jj + 2] * al + p * bflo(w.y); o[8 * jj + 3] = o[8 * jj + 3] * al + p * bfhi(w.y);
                o[8 * jj + 4] = o[8 * jj + 4] * al + p * bflo(w.z); o[8 * jj + 5] = o[8 * jj + 5] * al + p * bfhi(w.z); o[8 * jj + 6] = o[8 * jj + 6] * al + p * bflo(w.w); o[8 * jj + 7] = o[8 * jj + 7] * al + p * bfhi(w.w); }
        }
        const float rl = 1.0f / l; GAS v4u* yp = (GAS v4u*)(Y + row * D + 512 + h * 64);
#pragma unroll
        for (int jj = 0; jj < 8; ++jj) { v4u w; w.x = pk2(o[8 * jj] * rl, o[8 * jj + 1] * rl); w.y = pk2(o[8 * jj + 2] * rl, o[8 * jj + 3] * rl); w.z = pk2(o[8 * jj + 4] * rl, o[8 * jj + 5] * rl); w.w = pk2(o[8 * jj + 6] * rl, o[8 * jj + 7] * rl); yp[jj] = w; }
    }
}


namespace att {
using bf16x8 = __attribute__((ext_vector_type(8))) short;
using s16x4 = __attribute__((ext_vector_type(4))) short;
using f32x16 = __attribute__((ext_vector_type(16))) float;
using u32x4 = __attribute__((ext_vector_type(4))) unsigned;
typedef unsigned short bf16;
constexpr int KSLOT = 12288, VSLOT = 8192, NSLOT = 3;
constexpr int L_K = 0, L_V = NSLOT * KSLOT, L_WS = L_V + NSLOT * VSLOT, L_OST = L_WS + 8 * 64 * 4, L_END = L_OST + 8 * 4096;
__device__ __forceinline__ int crow(int r, int hi) { return (r & 3) + 8 * (r >> 2) + 4 * hi; }
__device__ __forceinline__ void glds16(const void* gsrc, unsigned lds_dst) { unsigned keep;
    asm volatile("s_mov_b32 %0, m0\n\ts_mov_b32 m0, %2\n\ts_nop 0\n\tglobal_load_lds_dwordx4 %1, off\n\ts_mov_b32 m0, %0" : "=&s"(keep) : "v"(gsrc), "s"(lds_dst) : "memory"); }
typedef float f32x2_t __attribute__((ext_vector_type(2))); typedef __bf16 bf16x2_t __attribute__((ext_vector_type(2)));
__device__ __forceinline__ unsigned cvtpk(float lo, float hi) { f32x2_t v = {lo, hi}; bf16x2_t b = __builtin_convertvector(v, bf16x2_t); return __builtin_bit_cast(unsigned, b); }
#define ATT_SBAR() __builtin_amdgcn_sched_barrier(0)

__device__ __forceinline__ void qkt(f32x16& p0, f32x16& p1, const char* Kslot, const bf16x8* qr, int r32, int hi) {
    const char* kb = Kslot + hi * 1024 + r32 * 16;
    p0 = f32x16{}; p1 = f32x16{};
#pragma unroll
    for (int d0 = 0; d0 < 6; ++d0) {
        const bf16x8 b0 = *reinterpret_cast<const bf16x8*>(kb + d0 * 2048);
        const bf16x8 b1 = *reinterpret_cast<const bf16x8*>(kb + d0 * 2048 + 512);
        p0 = __builtin_amdgcn_mfma_f32_32x32x16_bf16(b0, qr[d0], p0, 0, 0, 0); p1 = __builtin_amdgcn_mfma_f32_32x32x16_bf16(b1, qr[d0], p1, 0, 0, 0); }
}
__device__ __forceinline__ float rowmax(const f32x16& p0, const f32x16& p1) {
    float a = fmaxf(p0[0], p1[0]);
#pragma unroll
    for (int r = 1; r < 16; ++r) a = fmaxf(a, fmaxf(p0[r], p1[r]));
    auto rr = __builtin_amdgcn_permlane32_swap(__float_as_uint(a), __float_as_uint(a), false, false);
    return fmaxf(__uint_as_float(rr[0]), __uint_as_float(rr[1]));
}
__device__ __forceinline__ void pv(f32x16* o, int vb, bf16x8 pa0, bf16x8 pa1, bf16x8 pa2, bf16x8 pa3) {
#pragma unroll
    for (int d0 = 0; d0 < 2; ++d0) { s16x4 lo[4], hi[4];
#pragma unroll
        for (int ks = 0; ks < 4; ++ks) {
            asm volatile("ds_read_b64_tr_b16 %0,%1 offset:%c2" : "=&v"(lo[ks]) : "v"(vb), "i"(d0 * 4096 + ks * 1024) : "memory");
            asm volatile("ds_read_b64_tr_b16 %0,%1 offset:%c2" : "=&v"(hi[ks]) : "v"(vb), "i"(d0 * 4096 + ks * 1024 + 512) : "memory"); }
        asm volatile("s_waitcnt lgkmcnt(0)" ::: "memory"); ATT_SBAR();
#define ATT_PK(k) (bf16x8){lo[k][0], lo[k][1], lo[k][2], lo[k][3], hi[k][0], hi[k][1], hi[k][2], hi[k][3]}
        o[d0] = __builtin_amdgcn_mfma_f32_32x32x16_bf16(pa0, ATT_PK(0), o[d0], 0, 0, 0);
        o[d0] = __builtin_amdgcn_mfma_f32_32x32x16_bf16(pa1, ATT_PK(1), o[d0], 0, 0, 0);
        o[d0] = __builtin_amdgcn_mfma_f32_32x32x16_bf16(pa2, ATT_PK(2), o[d0], 0, 0, 0);
        o[d0] = __builtin_amdgcn_mfma_f32_32x32x16_bf16(pa3, ATT_PK(3), o[d0], 0, 0, 0);
#undef ATT_PK
    }
}
constexpr int SEQ_ = 4096, QW_ = 768, KVW_ = 1024, YW_ = 1024;
__device__ __forceinline__ void attn_unit(int b, int h, int qb, const bf16* Q, const bf16* __restrict__ KV, const bf16* __restrict__ KPE, bf16* Y, char* shm) {
    const int tid = threadIdx.x, lane = tid & 63, r32 = lane & 31, hi = lane >> 5; const int wid = __builtin_amdgcn_readfirstlane(tid >> 6);
    const long rowbase = (long)b * SEQ_; const int q0 = qb * 256;
    const bf16* Qw = Q + (rowbase + q0 + wid * 32) * QW_ + h * 96;
    const unsigned lds0 = (unsigned)(uintptr_t)shm;
    float* wsf = (float*)(shm + L_WS) + wid * 64;
    const bf16* ksrc = KV + (rowbase + lane) * KVW_ + h * 128 + wid * 8;
    const bf16* psrc = KPE + (rowbase + lane) * 32 + (wid & 3) * 8;
    const bf16* vsrc = KV + (rowbase + 16 * (wid & 3) + (lane >> 2)) * KVW_ + h * 128 + 64 + (wid >> 2) * 32 + (lane & 3) * 8;
    const unsigned kdst = lds0 + L_K + wid * 1024, pdst = lds0 + L_K + (8 + (wid & 3)) * 1024, vdst = lds0 + L_V + wid * 1024;
#define ATT_DMA(t, sl) do { glds16(ksrc + (long)(t) * 64 * KVW_, (unsigned)__builtin_amdgcn_readfirstlane(kdst + (sl) * KSLOT)); \
        glds16(psrc + (long)(t) * 64 * 32, (unsigned)__builtin_amdgcn_readfirstlane(pdst + (sl) * KSLOT)); \
        glds16(vsrc + (long)(t) * 64 * KVW_, (unsigned)__builtin_amdgcn_readfirstlane(vdst + (sl) * VSLOT)); } while (0)
    const int vb0 = (int)(lds0 + L_V) + ((lane >> 4) & 1) * 32 + (lane & 3) * 8 + (4 * hi + ((lane & 15) >> 2)) * 64;
    const int NT = 4 * qb + 4, tmax = 4 * qb + (wid >> 1);
    ATT_DMA(0, 0); ATT_DMA(1, 1);
    bf16x8 qr[6];
#pragma unroll
    for (int d0 = 0; d0 < 6; ++d0) qr[d0] = *reinterpret_cast<const bf16x8*>(&Qw[(long)r32 * QW_ + d0 * 16 + hi * 8]);
    float mrow = -1e30f, l_reg = 0.f; f32x16 o[2]; o[0] = f32x16{}; o[1] = f32x16{};
    int sl = 0, sl2 = 2;
    for (int t = 0; t < NT; ++t) {
        if (t + 1 < NT) asm volatile("s_waitcnt vmcnt(3)" ::: "memory"); else asm volatile("s_waitcnt vmcnt(0)" ::: "memory");
        asm volatile("s_waitcnt lgkmcnt(0)\n\ts_barrier" ::: "memory");
        if (t + 2 < NT) ATT_DMA(t + 2, sl2);
        if (t <= tmax) {
            f32x16 p0, p1;
            qkt(p0, p1, shm + L_K + sl * KSLOT, qr, r32, hi);
            const float rm = rowmax(p0, p1);
            const float mn = fmaxf(mrow, rm), al = __builtin_amdgcn_exp2f(mrow - mn); mrow = mn;
            float sacc = 0.f;
#pragma unroll
            for (int r = 0; r < 16; ++r) { p0[r] = __builtin_amdgcn_exp2f(p0[r] - mn); p1[r] = __builtin_amdgcn_exp2f(p1[r] - mn); sacc += p0[r] + p1[r]; }
            l_reg = l_reg * al + sacc;
            if (hi == 0) wsf[r32] = al;
            asm volatile("s_waitcnt lgkmcnt(0)" ::: "memory");
#pragma unroll
            for (int r = 0; r < 16; ++r) { const float f = wsf[crow(r, hi)]; o[0][r] *= f; o[1][r] *= f; }
            u32x4 pw0, pw1, pw2, pw3;
            pw0 = (u32x4){cvtpk(p0[0], p0[1]), cvtpk(p0[2], p0[3]), cvtpk(p0[4], p0[5]), cvtpk(p0[6], p0[7])};
            pw1 = (u32x4){cvtpk(p0[8], p0[9]), cvtpk(p0[10], p0[11]), cvtpk(p0[12], p0[13]), cvtpk(p0[14], p0[15])};
            pw2 = (u32x4){cvtpk(p1[0], p1[1]), cvtpk(p1[2], p1[3]), cvtpk(p1[4], p1[5]), cvtpk(p1[6], p1[7])};
            pw3 = (u32x4){cvtpk(p1[8], p1[9]), cvtpk(p1[10], p1[11]), cvtpk(p1[12], p1[13]), cvtpk(p1[14], p1[15])};
            ATT_SBAR();
            pv(o, vb0 + sl * VSLOT, __builtin_bit_cast(bf16x8, pw0), __builtin_bit_cast(bf16x8, pw1), __builtin_bit_cast(bf16x8, pw2), __builtin_bit_cast(bf16x8, pw3));
        }
        sl = (sl == NSLOT - 1) ? 0 : sl + 1; sl2 = (sl2 == NSLOT - 1) ? 0 : sl2 + 1;
    }
    { auto rr = __builtin_amdgcn_permlane32_swap(__float_as_uint(l_reg), __float_as_uint(l_reg), false, false); l_reg = __uint_as_float(rr[0]) + __uint_as_float(rr[1]); }
    if (hi == 0) wsf[32 + r32] = l_reg; asm volatile("s_waitcnt lgkmcnt(0)" ::: "memory");
    float rli[16];
#pragma unroll
    for (int r = 0; r < 16; ++r) rli[r] = __builtin_amdgcn_rcpf(wsf[32 + crow(r, hi)]);
    bf16* Ow = Y + (rowbase + q0 + wid * 32) * YW_ + 512 + h * 64;
    { bf16* stg = (bf16*)(shm + L_OST) + wid * 2048;
#pragma unroll
      for (int r = 0; r < 16; ++r) { const int orow = crow(r, hi);
#pragma unroll
          for (int d0 = 0; d0 < 2; ++d0) { const float v = o[d0][r] * rli[r]; const unsigned u = __builtin_bit_cast(unsigned, v); stg[orow * 64 + d0 * 32 + r32] = (bf16)((u + 0x7fffu + ((u >> 16) & 1u)) >> 16); } }
      asm volatile("s_waitcnt lgkmcnt(0)" ::: "memory");
#pragma unroll
      for (int i = 0; i < 4; ++i) { const int row = i * 8 + (lane >> 3), ch = lane & 7; const u32x4 v = *(const u32x4*)(stg + row * 64 + ch * 8); *(u32x4*)(Ow + (long)row * YW_ + ch * 8) = v; } }
    asm volatile("s_waitcnt vmcnt(0) lgkmcnt(0)\n\ts_barrier" ::: "memory");
#undef ATT_DMA
}
__device__ __forceinline__ void attn_phase(char* lds, int vcu, int G, const bf16* Q, const bf16* KV, const bf16* KPE, bf16* Y) {
    for (int v = vcu; v < 256; v += G) {
        const int bh = v >> 2, s = v & 3;
        for (int i = 0; i < 4; ++i) { const int qb = (i == 0) ? s : (i == 1) ? 7 - s : (i == 2) ? 8 + s : 15 - s; attn_unit(bh >> 3, bh & 7, qb, Q, KV, KPE, Y, lds); }
    }
}
#undef ATT_SBAR
}

#ifndef USE_MFMA_ATTN
#define USE_MFMA_ATTN 1
#endif
struct Args { const float* in[27]; float* out; unsigned char* ws; int ph_lo, ph_hi, li, pad; };
__global__ void __launch_bounds__(NWAVES * 64, 2) mega_fwd(Args args) {
    extern __shared__ __attribute__((aligned(16))) unsigned char lds[];
    Frame F;
    F.lds = (LAS unsigned char*)lds;
    F.MISC = (volatile LAS unsigned*)(F.lds + MISC_OFF);
    F.tid = threadIdx.x; F.lane = F.tid & 63; F.wave = __builtin_amdgcn_readfirstlane(F.tid >> 6);
    F.G = gridDim.x; { const int bx = blockIdx.x; F.vcu = (F.G % 8 == 0) ? (bx % 8) * (F.G / 8) + bx / 8 : bx; }
    unsigned char* ws = args.ws;
    F.ctl = (gu32*)(ws + WS_CTL);
    for (int u = F.tid; u < (LDS_BYTES - LDSCTL_OFF) / 4; u += NWAVES * 64) ((LAS unsigned*)(F.lds + LDSCTL_OFF))[u] = 0u;
    __syncthreads();
    XcdBarrier bar; bar.bar = (unsigned*)(F.ctl + CW_BAR); bar.x = 0; bar.st = nullptr;
    const int lo = args.ph_lo, hi = args.ph_hi;
    if (hi - lo > 1) bar = xcd_barrier_post((unsigned*)(F.ctl + CW_BAR), F.MISC + 8);

    const float* x = args.in[0]; const int* pos = (const int*)args.in[1];
    bf16* XN = (bf16*)(ws + WS_XN); bf16* HB = (bf16*)(ws + WS_HB); float* Fm = (float*)(ws + WS_F); bf16* Y = (bf16*)(ws + WS_Y);
    bf16* PROJ = (bf16*)(ws + WS_PROJ); bf16* GATES = (bf16*)(ws + WS_GATES); bf16* Qb = (bf16*)(ws + WS_Q); bf16* KVb = (bf16*)(ws + WS_KV);

#ifndef PROBE_REP
#define PROBE_REP 0
#endif
#define IN(k) (lo <= (k) && (k) < hi)
#define SEAM(k) do { if (IN(k) && IN((k) + 1)) { xcd_barrier(bar); } } while (0)
#define GEMM_SWIGLU(WOFF) do { pg8::Gemm g{XN, (const bf16*)(ws + (WOFF)), M, 2 * FF, D}; pg8::StaticOrder S; S.init(M, 2 * FF, F.G, (int)blockIdx.x); pg8::EpiSwiglu E{HB, FF}; \
        pg8::gemm_phase<pg8::EpiSwiglu, pg8::StaticOrder, PG8_ALIGN, PG8_SP2>(F.lds + RING_OFF, g, S, E); } while (0)
#define GEMM_F32(A_, WOFF, K_) do { pg8::Gemm g{(A_), (const bf16*)(ws + (WOFF)), M, D, (K_)}; pg8::StaticOrder S; S.init(M, D, F.G, (int)blockIdx.x); pg8::EpiF32 E{Fm, D}; \
        pg8::gemm_phase<pg8::EpiF32, pg8::StaticOrder, PG8_ALIGN, PG8_SP2>(F.lds + RING_OFF, g, S, E); } while (0)
#define GEMM_BF16(A_, WOFF, N_, K_, O_) do { pg8::Gemm g{(A_), (const bf16*)(ws + (WOFF)), M, (N_), (K_)}; pg8::StaticOrder S; S.init(M, (N_), F.G, (int)blockIdx.x); pg8::EpiBf16 E{(O_), (N_)}; \
        pg8::gemm_phase<pg8::EpiBf16, pg8::StaticOrder, PG8_ALIGN, PG8_SP2>(F.lds + RING_OFF, g, S, E); } while (0)
#define PH_BODY_0 { P0Args a{x, args.in[2], args.in[4], args.in[5], args.in[6], args.in[24], args.in[25], args.in[26], args.in[9], args.in[18], args.in[20], args.in[21], args.in[12], args.in[14], ws}; p0_prologue(F, a); }
    if (IN(0)) { PH_BODY_0; if ((PROBE_REP >> 0) & 1) { xcd_barrier(bar); PH_BODY_0; } }
    SEAM(0);
#define PH_BODY_1 GEMM_SWIGLU(WS_W1GU);
    if (IN(1)) { PH_BODY_1; if ((PROBE_REP >> 1) & 1) { xcd_barrier(bar); PH_BODY_1; } }
    SEAM(1);
#define PH_BODY_2 GEMM_F32(HB, WS_W1D, FF);
    if (IN(2)) { PH_BODY_2; if ((PROBE_REP >> 2) & 1) { xcd_barrier(bar); PH_BODY_2; } }
    SEAM(2);
#define PH_BODY_3 rowpass(F, Fm, x, args.out, args.in[3], 0.5f, args.in[7], XN);
    if (IN(3)) { PH_BODY_3; if ((PROBE_REP >> 3) & 1) { xcd_barrier(bar); PH_BODY_3; } }
    SEAM(3);
#define PH_BODY_4 GEMM_BF16(XN, WS_WIN, IN_PAD, D, PROJ);
    if (IN(4)) { PH_BODY_4; if ((PROBE_REP >> 4) & 1) { xcd_barrier(bar); PH_BODY_4; } }
    SEAM(4);
#define PH_BODY_5 { PrepArgs a{pos, args.in[17], args.in[19], args.in[10], args.in[11], ws}; prep_pass(F, a); }
    if (IN(5)) { PH_BODY_5; if ((PROBE_REP >> 5) & 1) { xcd_barrier(bar); PH_BODY_5; } }
    SEAM(5);
#define PH_BODY_6 { GEMM_BF16((const bf16*)(ws + WS_QLN), WS_WQB, QW, QLORA, Qb); GEMM_BF16((const bf16*)(ws + WS_KVLN), WS_WKVB, KVW, KVLORA, KVb); GEMM_BF16((const bf16*)(ws + WS_XC), WS_WLRU, 1024, LRU_W, GATES); }
    if (IN(6)) { PH_BODY_6; if ((PROBE_REP >> 6) & 1) { xcd_barrier(bar); PH_BODY_6; } }
    SEAM(6);
#define PH_SCAN1 { ScanArgs a{args.in[13], args.in[15], args.in[16], ws}; scan_pass1(F, a); }
    if (IN(7)) { qrope_pass(F, ws); PH_SCAN1; if ((PROBE_REP >> 14) & 1) { xcd_barrier(bar); PH_SCAN1; } }
    SEAM(7);
#if USE_MFMA_ATTN
#define PH_ATTN att::attn_phase((char*)lds + RING_OFF, F.vcu, F.G, Qb, KVb, (const bf16*)(ws + WS_KPE), Y)
#else
#define PH_ATTN attn_naive(F, ws)
#endif
#define PH_SCAN2 { ScanArgs a{args.in[13], args.in[15], args.in[16], ws}; scan_pass2(F, a); }
    if (IN(8)) { PH_SCAN2; PH_ATTN; if ((PROBE_REP >> 15) & 1) { xcd_barrier(bar); PH_SCAN2; } if ((PROBE_REP >> 16) & 1) { xcd_barrier(bar); PH_ATTN; } }
    SEAM(8);
#define PH_BODY_9 GEMM_F32(Y, WS_WOUT, D);
    if (IN(9)) { PH_BODY_9; if ((PROBE_REP >> 9) & 1) { xcd_barrier(bar); PH_BODY_9; } }
    SEAM(9);
#define PH_BODY_10 rowpass(F, Fm, args.out, args.out, args.in[8], 1.0f, args.in[22], XN);
    if (IN(10)) { PH_BODY_10; if ((PROBE_REP >> 10) & 1) { xcd_barrier(bar); PH_BODY_10; } }
    SEAM(10);
#define PH_BODY_11 GEMM_SWIGLU(WS_W2GU);
    if (IN(11)) { PH_BODY_11; if ((PROBE_REP >> 11) & 1) { xcd_barrier(bar); PH_BODY_11; } }
    SEAM(11);
#define PH_BODY_12 GEMM_F32(HB, WS_W2D, FF);
    if (IN(12)) { PH_BODY_12; if ((PROBE_REP >> 12) & 1) { xcd_barrier(bar); PH_BODY_12; } }
    SEAM(12);
#define PH_BODY_13 rowpass(F, Fm, args.out, args.out, args.in[23], 0.5f, nullptr, nullptr);
    if (IN(13)) { PH_BODY_13; if ((PROBE_REP >> 13) & 1) { xcd_barrier(bar); PH_BODY_13; } }
#undef IN
#undef SEAM
}

extern "C" void kernel_launch(void* const* d_in, const int* in_sizes, int n_in, void* d_out, int out_size, void* d_ws, size_t ws_size, hipStream_t stream) {
    static int grid = 0;
    if (grid == 0) {
        if (n_in != 27 || in_sizes[0] != M * D || out_size != M * D || ws_size < WS_END) { fprintf(stderr, "kernel_launch: unexpected shapes: n_in %d in0 %d out %d ws %zu (need %zu); nothing launched\n", n_in, n_in > 0 ? in_sizes[0] : -1, out_size, ws_size, (size_t)WS_END); grid = -1; return; }
        int dev = 0, cus = 0, per_cu = 0;
        if (hipGetDevice(&dev) != hipSuccess || hipDeviceGetAttribute(&cus, hipDeviceAttributeMultiprocessorCount, dev) != hipSuccess) { fprintf(stderr, "kernel_launch: device query failed\n"); grid = -1; return; }
        if (hipFuncSetAttribute((const void*)mega_fwd, hipFuncAttributeMaxDynamicSharedMemorySize, LDS_BYTES) != hipSuccess) { fprintf(stderr, "kernel_launch: hipFuncSetAttribute failed\n"); grid = -1; return; }
        if (hipOccupancyMaxActiveBlocksPerMultiprocessor(&per_cu, (const void*)mega_fwd, NWAVES * 64, LDS_BYTES) != hipSuccess || per_cu < 1)
            fprintf(stderr, "kernel_launch: note: occupancy query reports %d workgroups per CU\n", per_cu);
        (void)hipGetLastError();
        grid = cus;
    }
    if (grid < 0) return;
    if (hipMemsetAsync((char*)d_ws + WS_CTL, 0, CTL_ZERO_BYTES, stream) != hipSuccess) { fprintf(stderr, "kernel_launch: hipMemsetAsync failed\n"); return; }
    Args a{};
    for (int i = 0; i < 27; ++i) a.in[i] = (const float*)d_in[i];
    a.out = (float*)d_out; a.ws = (unsigned char*)d_ws;
#if MK_ONE_LAUNCH
    a.ph_lo = 0; a.ph_hi = N_PHASES; a.li = 0;
    hipLaunchKernelGGL(mega_fwd, dim3(grid), dim3(NWAVES * 64), LDS_BYTES, stream, a);
#else
    for (int li = 0; li < N_PHASES; ++li) { a.ph_lo = li; a.ph_hi = li + 1; a.li = li;
        hipLaunchKernelGGL(mega_fwd, dim3(grid), dim3(NWAVES * 64), LDS_BYTES, stream, a); }
#endif
    const hipError_t le = hipPeekAtLastError();
    if (le != hipSuccess) fprintf(stderr, "kernel_launch: launch failed: %s\n", hipGetErrorName(le));
}
```
